# Optimizing an MI355X kernel written in HIP

```python
import math
import jax
import jax.numpy as jnp
from jax import lax
import numpy as np

D_MODEL = 1024
BATCH = 4
SEQ = 8192
DEPTH = 4

BRANCH_WIDTH = D_MODEL // 2
HEAD_DIM = 128
N_HEADS = BRANCH_WIDTH // HEAD_DIM
N_BRANCHES = 3
CONV_WIDTH = 4
CHUNK = 64
SB_BLOCK = 128
N_META = 16
FRONT = SB_BLOCK
PAD_FRONT = FRONT - N_META
NORM_EPS = 1e-6
SPLIT_SIZES = (BRANCH_WIDTH, BRANCH_WIDTH, BRANCH_WIDTH, BRANCH_WIDTH,
               3 * BRANCH_WIDTH, BRANCH_WIDTH, N_HEADS, N_HEADS,
               BRANCH_WIDTH, BRANCH_WIDTH, BRANCH_WIDTH, BRANCH_WIDTH,
               N_BRANCHES * D_MODEL)
N_IN = 12 * BRANCH_WIDTH + 2 * N_HEADS + N_BRANCHES * D_MODEL

kernel_name = 'meta_sb_gdn_hgrn2_gated_hybrid'


def rms_norm(x, w):
    xf = x.astype(jnp.float32)
    y = xf * lax.rsqrt(jnp.mean(xf * xf, axis=-1, keepdims=True) + NORM_EPS)
    return (y * w.astype(jnp.float32)).astype(x.dtype)


def l2_norm(x):
    return x * lax.rsqrt(jnp.sum(x * x, axis=-1, keepdims=True) + NORM_EPS)


def causal_conv(x, w):
    t_len = x.shape[1]
    xp = jnp.pad(x, ((0, 0), (CONV_WIDTH - 1, 0), (0, 0)))
    y = xp[:, 0:t_len] * w[0]
    for i in range(1, CONV_WIDTH):
        y = y + xp[:, i:i + t_len] * w[i]
    return y


def stick_breaking_attention(q, k, v, key_valid):
    t_len, d = q.shape[2], q.shape[3]
    scale = d ** -0.5
    outs = []
    for blk in range(t_len // SB_BLOCK):
        q0 = blk * SB_BLOCK
        q1 = q0 + SB_BLOCK
        z = jnp.einsum('bhqd,bhkd->bhqk', q[:, :, q0:q1], k[:, :, :q1]) * scale
        t_idx = jnp.arange(q0, q1)[:, None]
        s_idx = jnp.arange(q1)[None, :]
        mask = (s_idx < t_idx) & key_valid[None, :q1]
        log_keep = jnp.where(mask, jax.nn.log_sigmoid(-z), 0.0)
        log_passed = lax.cumsum(log_keep, axis=3, reverse=True) - log_keep
        attn = jnp.where(mask, jnp.exp(jax.nn.log_sigmoid(z) + log_passed), 0.0)
        outs.append(jnp.einsum('bhqk,bhkd->bhqd', attn, v[:, :, :q1]))
    return jnp.concatenate(outs, axis=2)


def to_chunks(a):
    bsz, t_len, h = a.shape[0], a.shape[1], a.shape[2]
    a = a.reshape((bsz, t_len // CHUNK, CHUNK, h) + a.shape[3:])
    return jnp.moveaxis(a, 3, 1)


def from_chunks(o):
    bsz, h, n, c, dv = o.shape
    return jnp.moveaxis(o, 1, 3).reshape(bsz, n * c, h, dv)


def gated_delta_rule_chunked(q, k, v, beta, g):
    bsz, _, h, dk = q.shape
    dv = v.shape[-1]
    q = to_chunks(q) * (dk ** -0.5)
    k = to_chunks(k)
    v = to_chunks(v)
    beta = to_chunks(beta)
    G = jnp.cumsum(to_chunks(g), axis=-1)
    causal = np.tril(np.ones((CHUNK, CHUNK), dtype=bool))
    strict = np.tril(np.ones((CHUNK, CHUNK), dtype=bool), k=-1)
    decay = jnp.exp(jnp.where(causal, G[..., :, None] - G[..., None, :], -jnp.inf))
    k_beta = k * beta[..., None]
    m = jnp.where(strict, jnp.einsum('bhncd,bhnsd->bhncs', k_beta, k) * decay, 0.0)
    t_mat = m + jnp.eye(CHUNK, dtype=jnp.float32)
    u = lax.linalg.triangular_solve(t_mat, v * beta[..., None], left_side=True, lower=True, unit_diagonal=True)
    w = lax.linalg.triangular_solve(t_mat, k_beta * jnp.exp(G)[..., None], left_side=True, lower=True, unit_diagonal=True)
    a_qk = jnp.einsum('bhncd,bhnsd->bhncs', q, k) * decay
    q_dec = q * jnp.exp(G)[..., None]
    k_dec = k * jnp.exp(G[..., -1:] - G)[..., None]
    g_last = jnp.exp(G[..., -1])
    xs = tuple(jnp.moveaxis(a, 2, 0) for a in (u, w, a_qk, q_dec, k_dec, g_last))

    def step(state, inp):
        u_c, w_c, aqk_c, qd_c, kd_c, gl_c = inp
        v_new = u_c - jnp.einsum('bhcd,bhde->bhce', w_c, state)
        o = jnp.einsum('bhcd,bhde->bhce', qd_c, state) + jnp.einsum('bhcs,bhse->bhce', aqk_c, v_new)
        state = state * gl_c[..., None, None] + jnp.einsum('bhcd,bhce->bhde', kd_c, v_new)
        return state, o

    s0 = jnp.zeros((bsz, h, dk, dv), jnp.float32)
    _, o = lax.scan(step, s0, xs)
    return from_chunks(jnp.moveaxis(o, 0, 2))


def hgrn2_chunked(q, k, v, g):
    bsz, _, h, dk = q.shape
    dv = v.shape[-1]
    G = jnp.cumsum(to_chunks(g), axis=3)
    xs = tuple(jnp.moveaxis(a, 2, 0) for a in (to_chunks(q), to_chunks(k), to_chunks(v), G))
    causal = np.tril(np.ones((CHUNK, CHUNK), dtype=bool))[:, :, None]

    def step(state, inp):
        q_c, k_c, v_c, g_c = inp
        g_end = g_c[:, :, -1:, :]
        o_inter = jnp.einsum('bhcd,bhde->bhce', q_c * jnp.exp(g_c), state)
        diff = g_c[:, :, :, None, :] - g_c[:, :, None, :, :]
        dec = jnp.exp(jnp.where(causal, diff, -jnp.inf))
        a = jnp.einsum('bhid,bhjd,bhijd->bhij', q_c, k_c, dec)
        o = o_inter + jnp.einsum('bhij,bhje->bhie', a, v_c)
        state = state * jnp.exp(g_end)[:, :, 0, :, None] + jnp.einsum('bhcd,bhce->bhde', k_c * jnp.exp(g_end - g_c), v_c)
        return state, o

    s0 = jnp.zeros((bsz, h, dk, dv), jnp.float32)
    _, o = lax.scan(step, s0, xs)
    return from_chunks(jnp.moveaxis(o, 0, 2))


def hybrid_layer(h, valid, norm_w, w_in, sb_qn, sb_kn, conv_w, a_log, dt_bias, gdn_on, lb, hg_on, w_branch, w_out):
    bsz, t_len, _ = h.shape
    f32 = jnp.float32
    xn = rms_norm(h, norm_w)
    proj = jnp.einsum('btd,dn->btn', xn, w_in)
    split_points = np.cumsum(SPLIT_SIZES)[:-1].tolist()
    (sb_q, sb_k, sb_v, sb_z, gd_qkv, gd_z, gd_b, gd_a,
     hg_q, hg_f, hg_i, hg_z, mix) = jnp.split(proj, split_points, axis=-1)
    vmask = valid[None, :, None].astype(f32)

    def heads(a):
        return a.reshape(bsz, t_len, N_HEADS, HEAD_DIM)

    q = jnp.transpose(rms_norm(heads(sb_q), sb_qn).astype(f32), (0, 2, 1, 3))
    k = jnp.transpose(rms_norm(heads(sb_k), sb_kn).astype(f32), (0, 2, 1, 3))
    v = jnp.transpose(heads(sb_v).astype(f32), (0, 2, 1, 3))
    o_sb = stick_breaking_attention(q, k, v, valid)
    o_sb = jnp.transpose(o_sb, (0, 2, 1, 3)).reshape(bsz, t_len, BRANCH_WIDTH) * jax.nn.silu(sb_z.astype(f32))

    qkv = jax.nn.silu(causal_conv(gd_qkv.astype(f32), conv_w.astype(f32)))
    gq, gk, gv = jnp.split(qkv, 3, axis=-1)
    beta = jax.nn.sigmoid(gd_b.astype(f32)) * vmask
    g = -jnp.exp(a_log.astype(f32)) * jax.nn.softplus(gd_a.astype(f32) + dt_bias.astype(f32))
    o_gd = gated_delta_rule_chunked(l2_norm(heads(gq)), l2_norm(heads(gk)), heads(gv), beta, g)
    o_gd = rms_norm(o_gd, gdn_on).reshape(bsz, t_len, BRANCH_WIDTH) * jax.nn.silu(gd_z.astype(f32))

    lbf = lb.astype(f32)
    f_pre = hg_f.astype(f32)
    forget = lbf + (1.0 - lbf) * jax.nn.sigmoid(f_pre)
    hk = (1.0 - lbf) * jax.nn.sigmoid(-f_pre)
    o_hg = hgrn2_chunked(heads(jax.nn.silu(hg_q.astype(f32))), heads(hk),
                         heads(hg_i.astype(f32) * vmask), heads(jnp.log(forget)))
    o_hg = rms_norm(o_hg, hg_on).reshape(bsz, t_len, BRANCH_WIDTH) * jax.nn.silu(hg_z.astype(f32))

    gates = jax.nn.sigmoid(mix.astype(f32)).reshape(bsz, t_len, N_BRANCHES, D_MODEL)
    y = (gates[:, :, 0] * jnp.einsum('btw,wd->btd', o_sb, w_branch[0])
         + gates[:, :, 1] * jnp.einsum('btw,wd->btd', o_gd, w_branch[1])
         + gates[:, :, 2] * jnp.einsum('btw,wd->btd', o_hg, w_branch[2]))
    out = jnp.einsum('btd,de->bte', y.astype(h.dtype), w_out)
    return h + out.astype(h.dtype)


def setup_inputs(seed: int = 0) -> dict:
    key = jax.random.key(seed)
    ks = jax.random.split(key, 16)
    f32 = jnp.float32
    x = jax.random.normal(ks[0], (BATCH, SEQ, D_MODEL), f32)
    meta_tokens = jax.random.normal(ks[1], (N_META, D_MODEL), f32)
    norm_w = 1.0 + 0.02 * jax.random.normal(ks[2], (DEPTH, D_MODEL), f32)
    w_in = jax.random.normal(ks[3], (DEPTH, D_MODEL, N_IN), f32) * D_MODEL ** -0.5
    sb_q_norm = 1.0 + 0.02 * jax.random.normal(ks[4], (DEPTH, HEAD_DIM), f32)
    sb_k_norm = 1.0 + 0.02 * jax.random.normal(ks[5], (DEPTH, HEAD_DIM), f32)
    gdn_conv_w = jax.random.normal(ks[6], (DEPTH, CONV_WIDTH, 3 * BRANCH_WIDTH), f32) * CONV_WIDTH ** -0.5
    gdn_a_log = jnp.log(jax.random.uniform(ks[7], (DEPTH, N_HEADS), f32, 1.0, 16.0))
    dt = jnp.exp(jax.random.uniform(ks[8], (DEPTH, N_HEADS), f32) * (math.log(0.1) - math.log(0.001)) + math.log(0.001))
    gdn_dt_bias = dt + jnp.log(-jnp.expm1(-dt))
    gdn_out_norm = 1.0 + 0.02 * jax.random.normal(ks[9], (DEPTH, HEAD_DIM), f32)
    hgrn_lb_logits = jax.random.normal(ks[10], (DEPTH, BRANCH_WIDTH), f32)
    hgrn_out_norm = 1.0 + 0.02 * jax.random.normal(ks[11], (DEPTH, HEAD_DIM), f32)
    w_branch = jax.random.normal(ks[12], (DEPTH, N_BRANCHES, BRANCH_WIDTH, D_MODEL), f32) * BRANCH_WIDTH ** -0.5
    w_out = jax.random.normal(ks[13], (DEPTH, D_MODEL, D_MODEL), f32) * D_MODEL ** -0.5
    return {'x': x, 'meta_tokens': meta_tokens, 'norm_w': norm_w, 'w_in': w_in,
            'sb_q_norm': sb_q_norm, 'sb_k_norm': sb_k_norm, 'gdn_conv_w': gdn_conv_w,
            'gdn_a_log': gdn_a_log, 'gdn_dt_bias': gdn_dt_bias, 'gdn_out_norm': gdn_out_norm,
            'hgrn_lb_logits': hgrn_lb_logits, 'hgrn_out_norm': hgrn_out_norm,
            'w_branch': w_branch, 'w_out': w_out}


def reference(x, meta_tokens, norm_w, w_in, sb_q_norm, sb_k_norm, gdn_conv_w, gdn_a_log,
              gdn_dt_bias, gdn_out_norm, hgrn_lb_logits, hgrn_out_norm, w_branch, w_out):
    bsz = x.shape[0]
    h = jnp.concatenate([
        jnp.zeros((bsz, PAD_FRONT, D_MODEL), x.dtype),
        jnp.broadcast_to(meta_tokens.astype(x.dtype)[None], (bsz, N_META, D_MODEL)),
        x], axis=1)
    t_len = h.shape[1]
    valid = jnp.arange(t_len) >= PAD_FRONT
    p = jax.nn.softmax(hgrn_lb_logits.astype(jnp.float32), axis=0)
    lower_bounds = jnp.cumsum(p, axis=0) - p[0:1]
    for layer in range(DEPTH):
        h = hybrid_layer(h, valid, norm_w[layer], w_in[layer], sb_q_norm[layer], sb_k_norm[layer],
                         gdn_conv_w[layer], gdn_a_log[layer], gdn_dt_bias[layer], gdn_out_norm[layer],
                         lower_bounds[layer], hgrn_out_norm[layer], w_branch[layer], w_out[layer])
    return h[:, FRONT:]
```

```cpp
#include <hip/hip_runtime.h>
#include <cstdio>
#include <cstdint>
namespace pg8 {
#define PG8_LAS __attribute__((address_space(3)))
typedef unsigned short bf16_t;
typedef short bf16x8 __attribute__((ext_vector_type(8)));
typedef float f32x4 __attribute__((ext_vector_type(4)));
typedef unsigned u32x4 __attribute__((ext_vector_type(4)));
typedef unsigned u32x2 __attribute__((ext_vector_type(2)));
constexpr int BM = 256, BK = 64, HALF = 128, HTB = HALF * BK * 2  , STAGE_BYTES = 8 * HTB, NXCD = 8, WGM = 8;

__host__ __device__ __forceinline__ int lds_byte(int r, int c) { const int st = (r >> 4) * 2 + (c >> 5), rr = r & 15, cc = c & 31, ob = rr * 64 + cc * 2; return st * 1024 + (ob ^ (((ob >> 9) & 1) << 5)); }
__host__ __device__ __forceinline__ void stage_rc(int b, int& R, int& C) { const int st = b / 1024, sb = b % 1024, swz = sb ^ (((sb >> 9) & 1) << 5); R = (st >> 1) * 16 + swz / 64; C = (st & 1) * 32 + (swz % 64) / 2; }
__host__ __device__ __forceinline__ int perm32(int rho) { const int n = rho >> 4, i = rho & 15; return 8 * (i >> 2) + 4 * n + (i & 3); }

struct Unit { int pm, pn, rb; };
struct Gemm { const bf16_t* A; const bf16_t* Bt; int M, N, K; int nseg = 1; size_t segA = 0, segB = 0; };

struct StaticOrder {
    int nM, nN, nwg, G, c, remap;
    __host__ __device__ void init(int M, int N, int G_, int c_, int remap_ = 0) { nM = M / BM; nN = N / BM; nwg = nM * nN; G = G_; c = c_; remap = remap_; }
    __host__ __device__ bool next(int i, Unit& u) const {
        const long L = (long)i * G + c; if (L >= nwg) return false;
        int wgid = (int)L; { const int q = nwg / NXCD, r = nwg % NXCD, xcd = wgid % NXCD, off = wgid / NXCD; wgid = (xcd < r ? xcd * (q + 1) : r * (q + 1) + (xcd - r) * q) + off; }
        const int nig = WGM * nN, gid = wgid / nig, fm = gid * WGM, gsz = (nM - fm) < WGM ? (nM - fm) : WGM;
        u.pm = fm + ((wgid % nig) % gsz); u.pn = (wgid % nig) / gsz;
        u.rb = remap ? ((u.pm >> 5) * 8320 + 128 + 256 * (u.pm & 31)) : u.pm * BM;
        return true;
    }
    __device__ __forceinline__ void a_ready(const Unit&) const {}
    __device__ __forceinline__ void done(const Unit&) const {}
};
struct RangeOrder : StaticOrder { int i0, i1;
    __host__ __device__ bool next(int i, Unit& u) const { return (i0 + i < i1) && StaticOrder::next(i0 + i, u); } };
typedef float f32x2 __attribute__((ext_vector_type(2)));
typedef __bf16 pg8_bf16x2 __attribute__((ext_vector_type(2)));
__device__ __forceinline__ unsigned cvt_pk_bf16(float lo, float hi) { const f32x2 v = {lo, hi}; const pg8_bf16x2 b = __builtin_convertvector(v, pg8_bf16x2); return __builtin_bit_cast(unsigned, b); }
template <class Epi, class Sched, bool ALIGN_EPI = false, bool SP2 = false>
__device__ __forceinline__ void gemm_phase(PG8_LAS unsigned char* lds, const Gemm g, const Sched& S, const Epi& E, int tid_in) {
    int tid_l = tid_in; asm volatile("" : "+v"(tid_l));
    const int tid = tid_l, wid = __builtin_amdgcn_readfirstlane(tid >> 6), lane = tid & 63, wr = wid >> 2, wc = wid & 3, fr = lane & 15, fq = lane >> 4;
    const int K = g.K, nts = K / BK, nt = nts * g.nseg;
    unsigned voffA[2], voffB[2];
#pragma unroll
    for (int i = 0; i < 2; ++i) { int R, C; stage_rc(tid * 16 + i * 8192, R, C); const int Rb = Epi::PERM ? ((R & ~31) + perm32(R & 31)) : R;
        voffA[i] = (unsigned)(R * K + C) * 2u; voffB[i] = (unsigned)(Rb * K + C) * 2u; }
    const size_t kstep = (size_t)(BK * 2);
    const size_t hstep = (size_t)HALF * K * 2;
    const size_t tstep = 2 * hstep;
    const unsigned ldsw = (unsigned)wid * 1024u;
    const int aoff = lds_byte(wr * 64 + fr, fq * 8), boff = lds_byte(wc * 32 + fr, fq * 8);
#define PG8_SA(b, h) (((b) * 2 + (h)) * HTB)
#define PG8_SB(b, h) ((4 + (b) * 2 + (h)) * HTB)
#define PG8_STAGE(bufoff, gbase, voff) do { _Pragma("unroll") for (int _i = 0; _i < 2; ++_i) \
        __builtin_amdgcn_global_load_lds((const unsigned*)((const char*)(gbase) + (voff)[_i]), (PG8_LAS unsigned*)(lds + (bufoff) + ldsw + _i * 8192), 16, 0, 0); } while (0)
#define PG8_LDA(dst, b, h) do { _Pragma("unroll") for (int m = 0; m < 4; ++m) _Pragma("unroll") for (int k = 0; k < 2; ++k) dst[m][k] = *(const PG8_LAS bf16x8*)(lds + PG8_SA(b, h) + aoff + m * 2048 + k * 1024); } while (0)
#define PG8_LDB(dst, b, h) do { _Pragma("unroll") for (int n = 0; n < 2; ++n) _Pragma("unroll") for (int k = 0; k < 2; ++k) dst[n][k] = *(const PG8_LAS bf16x8*)(lds + PG8_SB(b, h) + boff + n * 2048 + k * 1024); } while (0)
#define PG8_MMA(ai, bj, At, Bt) do { __builtin_amdgcn_s_setprio(1); _Pragma("unroll") for (int m = 0; m < 4; ++m) _Pragma("unroll") for (int n = 0; n < 2; ++n) _Pragma("unroll") for (int k = 0; k < 2; ++k) \
        acc[ai][bj][m][n] = __builtin_amdgcn_mfma_f32_16x16x32_bf16(Bt[n][k], At[m][k], acc[ai][bj][m][n], 0, 0, 0); __builtin_amdgcn_s_setprio(0); } while (0)
#define PG8_WAIT_V(n) asm volatile("s_waitcnt vmcnt(" #n ")" ::: "memory")
#define PG8_WAIT_L(n) asm volatile("s_waitcnt lgkmcnt(" #n ")" ::: "memory")
#define PG8_BAR __builtin_amdgcn_s_barrier()
#define PG8_SCHED __builtin_amdgcn_sched_barrier(0)
    Unit cur, nxt; int ui = 0;
    if (!S.next(0, cur)) return;
    f32x4 acc[2][2][4][2];
#pragma unroll
    for (int a = 0; a < 2; ++a)
#pragma unroll
        for (int b = 0; b < 2; ++b)
#pragma unroll
            for (int m = 0; m < 4; ++m)
#pragma unroll
                for (int n = 0; n < 2; ++n) acc[a][b][m][n] = (f32x4){0.f, 0.f, 0.f, 0.f};
    bf16x8 At[4][2], B0[2][2], B1[2][2];
    const char* cA = (const char*)g.A + (size_t)cur.rb * K * 2; const char* cB = (const char*)g.Bt + (size_t)cur.pn * tstep;
    S.a_ready(cur);
    if constexpr (SP2) {
        PG8_STAGE(PG8_SB(0, 0), cB, voffB); PG8_STAGE(PG8_SB(0, 1), cB + hstep, voffB); PG8_STAGE(PG8_SA(0, 0), cA, voffA); PG8_STAGE(PG8_SA(0, 1), cA + hstep, voffA);
        if (wr == 1) PG8_BAR;
        PG8_WAIT_V(2); PG8_BAR;
        PG8_STAGE(PG8_SB(1, 0), cB + kstep, voffB); PG8_STAGE(PG8_SA(1, 0), cA + kstep, voffA); PG8_STAGE(PG8_SB(1, 1), cB + hstep + kstep, voffB);
        PG8_WAIT_V(6); PG8_BAR;
    } else {
        PG8_STAGE(PG8_SB(0, 0), cB, voffB); PG8_STAGE(PG8_SA(0, 0), cA, voffA); PG8_STAGE(PG8_SB(0, 1), cB + hstep, voffB); PG8_STAGE(PG8_SA(0, 1), cA + hstep, voffA);
        if (wr == 1) PG8_BAR;
        PG8_WAIT_V(4); PG8_BAR;
        PG8_STAGE(PG8_SB(1, 0), cB + kstep, voffB); PG8_STAGE(PG8_SA(1, 0), cA + kstep, voffA); PG8_STAGE(PG8_SB(1, 1), cB + hstep + kstep, voffB);
        PG8_WAIT_V(6); PG8_BAR;
    }
    for (;;) {
        const bool has_next = S.next(ui + 1, nxt);
        const char* nA = has_next ? (const char*)g.A + (size_t)nxt.rb * K * 2 : cA; const char* nB = has_next ? (const char*)g.Bt + (size_t)nxt.pn * tstep : cB;
        for (int t = 0; t < nt; t += 2) {
            const bool last = (t == nt - 2);
#define PG8_AT(base, seg, tt) ((base) + (size_t)((tt) / nts) * (seg) + (size_t)((tt) % nts) * kstep)
            const char* a1 = PG8_AT(cA, g.segA, t + 1);
            const char* a2 = last ? nA : PG8_AT(cA, g.segA, t + 2); const char* b2 = last ? nB : PG8_AT(cB, g.segB, t + 2);
            const char* a3 = last ? nA + kstep : PG8_AT(cA, g.segA, t + 3); const char* b3 = last ? nB + kstep : PG8_AT(cB, g.segB, t + 3);
#undef PG8_AT
            if constexpr (Epi::SEG) { if (t > 0 && t % nts == 0) E.seg_switch(acc, cur, t / nts, wr, wc, fr, fq); }
            if (last && has_next) S.a_ready(nxt);
            if constexpr (SP2) {
            PG8_LDB(B0, 0, 0); PG8_LDB(B1, 0, 1); PG8_SCHED; PG8_LDA(At, 0, 0); PG8_STAGE(PG8_SA(1, 1), a1 + hstep, voffA);
            PG8_WAIT_V(8); PG8_WAIT_L(0); PG8_BAR; PG8_MMA(0, 0, At, B0); PG8_MMA(0, 1, At, B1); PG8_BAR; PG8_SCHED;
            PG8_LDA(At, 0, 1); PG8_STAGE(PG8_SB(0, 0), b2, voffB); PG8_STAGE(PG8_SB(0, 1), b2 + hstep, voffB); PG8_STAGE(PG8_SA(0, 0), a2, voffA);
            PG8_WAIT_V(8); PG8_WAIT_L(0); PG8_BAR; PG8_MMA(1, 0, At, B0); PG8_MMA(1, 1, At, B1); PG8_BAR; PG8_SCHED;
            PG8_LDB(B0, 1, 0); PG8_LDB(B1, 1, 1); PG8_SCHED; PG8_LDA(At, 1, 0); PG8_STAGE(PG8_SA(0, 1), a2 + hstep, voffA);
            PG8_WAIT_V(8); PG8_WAIT_L(0); PG8_BAR; PG8_MMA(0, 0, At, B0); PG8_MMA(0, 1, At, B1); PG8_BAR; PG8_SCHED;
            PG8_LDA(At, 1, 1); PG8_STAGE(PG8_SB(1, 0), b3, voffB); PG8_STAGE(PG8_SB(1, 1), b3 + hstep, voffB); PG8_STAGE(PG8_SA(1, 0), a3, voffA);
            PG8_WAIT_V(8); PG8_WAIT_L(0); PG8_BAR; PG8_MMA(1, 0, At, B0); PG8_MMA(1, 1, At, B1); PG8_BAR; PG8_SCHED;
            } else {
            PG8_LDB(B0, 0, 0); PG8_SCHED; PG8_LDA(At, 0, 0); PG8_STAGE(PG8_SA(1, 1), a1 + hstep, voffA);
            PG8_WAIT_L(8); PG8_BAR; PG8_WAIT_L(0); PG8_MMA(0, 0, At, B0); PG8_BAR; PG8_SCHED;
            PG8_LDB(B1, 0, 1); PG8_STAGE(PG8_SB(0, 0), b2, voffB);
            PG8_BAR; PG8_WAIT_L(0); PG8_MMA(0, 1, At, B1); PG8_BAR;
            PG8_LDA(At, 0, 1); PG8_STAGE(PG8_SA(0, 0), a2, voffA);
            PG8_BAR; PG8_WAIT_L(0); PG8_MMA(1, 0, At, B0); PG8_BAR; PG8_SCHED;
            PG8_STAGE(PG8_SB(0, 1), b2 + hstep, voffB);
            PG8_WAIT_V(6); PG8_BAR; PG8_MMA(1, 1, At, B1); PG8_BAR;
            PG8_LDB(B0, 1, 0); PG8_SCHED; PG8_LDA(At, 1, 0); PG8_STAGE(PG8_SA(0, 1), a2 + hstep, voffA);
            PG8_WAIT_L(8); PG8_BAR; PG8_WAIT_L(0); PG8_MMA(0, 0, At, B0); PG8_BAR; PG8_SCHED;
            PG8_LDB(B1, 1, 1); PG8_STAGE(PG8_SB(1, 0), b3, voffB);
            PG8_BAR; PG8_WAIT_L(0); PG8_MMA(0, 1, At, B1); PG8_BAR;
            PG8_LDA(At, 1, 1); PG8_STAGE(PG8_SA(1, 0), a3, voffA);
            PG8_BAR; PG8_WAIT_L(0); PG8_MMA(1, 0, At, B0); PG8_BAR; PG8_SCHED;
            PG8_STAGE(PG8_SB(1, 1), b3 + hstep, voffB);
            PG8_WAIT_V(6); PG8_BAR; PG8_MMA(1, 1, At, B1); PG8_BAR;
            }
        }
        if constexpr (ALIGN_EPI) { if (wr == 0) PG8_BAR; }
        if constexpr (!Epi::AFTER_DRAIN) { E(acc, cur, wr, wc, fr, fq); S.done(cur); }
        if (!has_next) break;
#pragma unroll
        for (int a = 0; a < 2; ++a)
#pragma unroll
            for (int b = 0; b < 2; ++b)
#pragma unroll
                for (int m = 0; m < 4; ++m)
#pragma unroll
                    for (int n = 0; n < 2; ++n) acc[a][b][m][n] = (f32x4){0.f, 0.f, 0.f, 0.f};
        cur = nxt; cA = nA; cB = nB; ++ui;
        if constexpr (ALIGN_EPI) { if (wr == 1) PG8_BAR; }
    }
    PG8_WAIT_V(0);
    if constexpr (!ALIGN_EPI) { if (wr == 0) PG8_BAR; }
    PG8_BAR;
    if constexpr (Epi::AFTER_DRAIN) { E.fused(acc, cur, wr, wc, fr, fq, lds, wid, lane); S.done(cur); }
#undef PG8_SA
#undef PG8_SB
#undef PG8_STAGE
#undef PG8_LDA
#undef PG8_LDB
#undef PG8_MMA
#undef PG8_WAIT_V
#undef PG8_WAIT_L
#undef PG8_BAR
#undef PG8_SCHED
}
}

constexpr int NB = 4, TP = 8320, TREAL = 8192, FRONTR = 128, PADF = 112, DM = 1024, BW = 512, HD = 128, NH = 4, NLAYER = 4;
constexpr int R = NB * TP;
constexpr int NIN = 9224;
constexpr int NA = 4608, NZM = 4608, NINP = NA + NZM;
constexpr float EPS = 1e-6f;
constexpr float QSCALE = 0.08838834764831845f;

constexpr size_t MiB = 1u << 20;
constexpr size_t WS_CTL = 0, CTL_ZERO_BYTES = 1 * MiB;
constexpr size_t WS_FRONT = 1 * MiB;
constexpr size_t WS_BETA = 3 * MiB;
constexpr size_t WS_GG = WS_BETA + (size_t)R * 4 * 4;
constexpr size_t WS_LB = WS_GG + (size_t)R * 4 * 4;
constexpr size_t WS_WBA = WS_LB + 8192;
constexpr size_t WS_W = WS_WBA + 131072;
constexpr size_t W_IN_BYTES = (size_t)NINP * DM * 2, W_B_BYTES = (size_t)3 * DM * BW * 2, W_O_BYTES = (size_t)DM * DM * 2;
constexpr size_t W_LAYER_BYTES = W_IN_BYTES + W_B_BYTES + W_O_BYTES;
constexpr size_t WS_XN = WS_W + W_LAYER_BYTES;
constexpr size_t ARR_BYTES = (size_t)R * BW * 2;
constexpr size_t WS_ARR = WS_XN + (size_t)R * DM * 2;
constexpr size_t WS_O = WS_ARR + 8 * ARR_BYTES;
constexpr size_t WS_SSQ = WS_ARR + 11 * ARR_BYTES;
constexpr size_t WS_DEND = WS_SSQ + (size_t)R * 16 * 4;
constexpr int NCH = TP / 64;
constexpr size_t WS_GL = WS_DEND + (size_t)16 * NCH * 128 * 4;
constexpr size_t WS_HALO = WS_GL + 16384;
constexpr size_t WS_AQK = WS_HALO + (size_t)3 * (R / 64) * 3 * BW * 2 + 4096;
constexpr size_t WS_RKT = WS_AQK + (size_t)R * 256 * 2;
constexpr size_t WS_MIX = WS_RKT + (size_t)R * 4 * 4;
constexpr size_t WS_YF = WS_MIX + (size_t)3 * R * DM;
constexpr size_t WS_ZF = WS_YF + 32768;
constexpr size_t WS_END = WS_ZF + 16 * 1536 * 4;
static_assert(WS_W % 256 == 0 && WS_XN % 256 == 0 && WS_ARR % 256 == 0 && WS_SSQ % 256 == 0 && WS_MIX % 256 == 0, "ws alignment");
constexpr int CW_BAR = 4096;

constexpr int LDS_BYTES = 147456;
constexpr int RING_BYTES = 131072, LDS_CTL = 147200, MISC_OFF = LDS_CTL + 64;

#define GAS __attribute__((address_space(1)))
#define LAS __attribute__((address_space(3)))
typedef unsigned short bf16;
typedef unsigned v4u __attribute__((ext_vector_type(4)));
typedef unsigned v2u __attribute__((ext_vector_type(2)));
typedef float f32x4 __attribute__((ext_vector_type(4)));
#define LDS_WAIT() asm volatile("s_waitcnt lgkmcnt(0)" ::: "memory")
#define LDS_BARRIER() do { asm volatile("s_waitcnt lgkmcnt(0)" ::: "memory"); __builtin_amdgcn_s_barrier(); asm volatile("" ::: "memory"); } while (0)
#define VM_WAIT() asm volatile("s_waitcnt vmcnt(0)" ::: "memory")
typedef float f32x2_t __attribute__((ext_vector_type(2))); typedef __bf16 bf16x2_t __attribute__((ext_vector_type(2)));
__device__ __forceinline__ unsigned pk2(float lo, float hi) { const f32x2_t v = {lo, hi}; const bf16x2_t b = __builtin_convertvector(v, bf16x2_t); return __builtin_bit_cast(unsigned, b); }
__device__ __forceinline__ unsigned f2bf(float f) { return pk2(f, 0.f) & 0xffffu; }
__device__ __forceinline__ float bflo(unsigned w) { return __builtin_bit_cast(float, w << 16); }
__device__ __forceinline__ float bfhi(unsigned w) { return __builtin_bit_cast(float, w & 0xffff0000u); }
__device__ __forceinline__ float bf2f(bf16 x) { return __builtin_bit_cast(float, ((unsigned)x) << 16); }
__device__ __forceinline__ float sigmoidf_(float x) { return __builtin_amdgcn_rcpf(1.f + __builtin_amdgcn_exp2f(-1.4426950408889634f * x)); }
__device__ __forceinline__ float softplusf_(float x) { return fmaxf(x, 0.f) + __logf(1.f + __expf(-fabsf(x))); }
__device__ __forceinline__ int fresh_lane() { int l; asm volatile("v_mbcnt_lo_u32_b32 %0, -1, 0\n\tv_mbcnt_hi_u32_b32 %0, -1, %0" : "=v"(l)); return l; }
template <int MASK> __device__ __forceinline__ float shx(float v) {
    if constexpr (MASK == 32) { auto rr = __builtin_amdgcn_permlane32_swap(__float_as_uint(v), __float_as_uint(v), false, false);
        const unsigned lo = rr[0], hi = rr[1]; const bool up = (fresh_lane() & 32) != 0; return __uint_as_float(up ? lo : hi); }
    else return __uint_as_float((unsigned)__builtin_amdgcn_ds_swizzle((int)__float_as_uint(v), (MASK << 10) | 0x1f));
}
template <int CTRL> __device__ __forceinline__ float dpp_add(float v) { return v + __uint_as_float((unsigned)__builtin_amdgcn_update_dpp(0, (int)__float_as_uint(v), CTRL, 0xf, 0xf, true)); }
__device__ __forceinline__ float red4(float v) { v = dpp_add<0xB1>(v); return dpp_add<0x4E>(v); }
__device__ __forceinline__ float red8(float v) { return dpp_add<0x141>(red4(v)); }
__device__ __forceinline__ float rows_sum(float v) {
    auto r16 = __builtin_amdgcn_permlane16_swap(__float_as_uint(v), __float_as_uint(v), false, false); v = __uint_as_float(r16[0]) + __uint_as_float(r16[1]);
    auto rr = __builtin_amdgcn_permlane32_swap(__float_as_uint(v), __float_as_uint(v), false, false); return __uint_as_float(rr[0]) + __uint_as_float(rr[1]);
}
__device__ __forceinline__ float wave_sum(float v) { return rows_sum(dpp_add<0x140>(red8(v))); }

#define XB_TMO      128
#define XB_XCNT(j)  (256  + 64 * (j))
#define XB_XSUB(j)  (1280 + 64 * (j))
#define XB_XGEN(j)  (2304 + 64 * (j))
#define XB_TOP      3328
#define XB_TOPGEN   3392
#define XCD_BAR_WORDS 3456
#define XB_SPIN_CAP (1u << 18)

__device__ __forceinline__ unsigned xb_ld(unsigned* p)              { return __hip_atomic_load(p, __ATOMIC_RELAXED, __HIP_MEMORY_SCOPE_AGENT); }
__device__ __forceinline__ unsigned xb_add(unsigned* p, unsigned v) { return __hip_atomic_fetch_add(p, v, __ATOMIC_RELAXED, __HIP_MEMORY_SCOPE_AGENT); }
__device__ __forceinline__ unsigned xb_xcc_id() { return (unsigned)__builtin_amdgcn_s_getreg((3 << 11) | 20) & 0xFu; }
#define XB_SPIN(cond, bar) do { unsigned _sp = 0; while (cond) { __builtin_amdgcn_s_sleep(1); \
    if ((++_sp & 255u) == 0u) { if (xb_ld(&(bar)[XB_TMO])) break; if (_sp > XB_SPIN_CAP) { atomicAdd(&(bar)[XB_TMO], 1u); break; } } } } while (0)

struct XcdBarrier {
    unsigned* bar; unsigned x;
    volatile LAS unsigned* st;
};

__device__ __forceinline__ XcdBarrier xcd_barrier_post(unsigned* bar, volatile LAS unsigned* st, int tid) {
    XcdBarrier b; b.bar = bar; b.x = xb_xcc_id(); b.st = st;
    if (tid == 0) (void)xb_add(&bar[XB_XCNT(b.x)], 1u);
    return b;
}
__device__ __forceinline__ void xcd_barrier_complete(unsigned* bar, unsigned x, unsigned& nloc, unsigned& nx) {
    const unsigned G = gridDim.x * gridDim.y * gridDim.z;
    unsigned sum, cnt, mine, sp = 0u;
    for (;;) {
        sum = 0u; cnt = 0u; mine = 0u;
#pragma unroll
        for (unsigned j = 0; j < 16; ++j) { const unsigned c = xb_ld(&bar[XB_XCNT(j)]); sum += c; cnt += (c > 0u) ? 1u : 0u; mine = (j == x) ? c : mine; }
        if (sum == G) break;
        __builtin_amdgcn_s_sleep(1);
        if ((++sp & 255u) == 0u) { if (xb_ld(&bar[XB_TMO])) break; if (sp > XB_SPIN_CAP) { atomicAdd(&bar[XB_TMO], 1u); break; } }
    }
    nloc = mine > 0u ? mine : 1u; nx = cnt > 0u ? cnt : 1u;
}

__device__ __forceinline__ void xcd_barrier(const XcdBarrier& b, int tid) {
    asm volatile("s_waitcnt vmcnt(0)" ::: "memory");
    __syncthreads();
    if (tid == 0) {
        unsigned* bar = b.bar;
        __builtin_amdgcn_s_waitcnt(0);
        unsigned nloc = b.st[0], nx = b.st[1];
        if (nloc == 0u) { xcd_barrier_complete(bar, b.x, nloc, nx); b.st[0] = nloc; b.st[1] = nx; }
        const unsigned old = xb_add(&bar[XB_XSUB(b.x)], 1u);
        const unsigned gen = old / nloc;
        if (old + 1u == (gen + 1u) * nloc) {
            __builtin_amdgcn_fence(__ATOMIC_RELEASE, "agent");
            asm volatile("s_waitcnt vmcnt(0)" ::: "memory");
            const unsigned og = xb_add(&bar[XB_TOP], 1u);
            const unsigned tg = og / nx;
            if (og + 1u == (tg + 1u) * nx) xb_add(&bar[XB_TOPGEN], 1u);
            else XB_SPIN(xb_ld(&bar[XB_TOPGEN]) == tg, bar);
            __builtin_amdgcn_fence(__ATOMIC_ACQUIRE, "agent");
            xb_add(&bar[XB_XGEN(b.x)], 1u);
            asm volatile("s_waitcnt vmcnt(0)" ::: "memory");
        } else {
            XB_SPIN(xb_ld(&bar[XB_XGEN(b.x)]) == gen, bar);
            __builtin_amdgcn_fence(__ATOMIC_ACQUIRE, "agent");
            asm volatile("s_waitcnt vmcnt(0)" ::: "memory");
        }
    }
    __syncthreads();
}

#define GLOBAL_AS __attribute__((address_space(1)))
template <class T> __device__ __forceinline__ T* gp(T* p) { return (T*)(GLOBAL_AS T*)p; }
struct Args {
    const float* x; const float* meta; const float* norm_w; const float* w_in; const float* sb_qn; const float* sb_kn; const float* conv_w;
    const float* a_log; const float* dt_bias; const float* gdn_on; const float* lb_logits; const float* hg_on; const float* w_branch; const float* w_out;
    float* out; unsigned char* ws;
};

__device__ __forceinline__ float* hrow(float* front, float* big, int m) {
    const int b = m / TP, t = m - b * TP;
    return t < FRONTR ? front + (size_t)(b * FRONTR + t) * DM : big + ((size_t)b * TREAL + (t - FRONTR)) * DM;
}

namespace pg8 {
struct EpiSplit {
    static constexpr bool PERM = true, AFTER_DRAIN = false, SEG = false;
    bf16_t* O; float* SSQ; bf16_t* HALO;
    __device__ __forceinline__ void operator()(const f32x4 (&acc)[2][2][4][2], const Unit& u, int wr, int wc, int fr, int fq) const {
        const int row0 = u.rb + wr * 64 + fr; const int colt = u.pn * BM; const int t = colt >> 9;
        bf16_t* base = O + (size_t)t * ((size_t)R * BW); const int col0 = (colt & 511) + wc * 32 + 8 * fq;
#pragma unroll
        for (int ai = 0; ai < 2; ++ai)
#pragma unroll
            for (int m = 0; m < 4; ++m) { bf16_t* rowp = base + (size_t)(row0 + ai * HALF + m * 16) * BW + col0;
#pragma unroll
                for (int bj = 0; bj < 2; ++bj) { const f32x4 v0 = acc[ai][bj][m][0], v1 = acc[ai][bj][m][1];
                    u32x4 w; w.x = cvt_pk_bf16(v0[0], v0[1]); w.y = cvt_pk_bf16(v0[2], v0[3]); w.z = cvt_pk_bf16(v1[0], v1[1]); w.w = cvt_pk_bf16(v1[2], v1[3]);
                    *(u32x4*)(rowp + bj * HALF) = w; } }
        if (t >= 2 && t <= 4 && fr >= 13) {
#pragma unroll
            for (int ai = 0; ai < 2; ++ai) { const int row = row0 + ai * HALF + 48; bf16_t* hp = HALO + (((size_t)(t - 2) * (R / 64) + (row >> 6)) * 3 + (fr - 13)) * BW + (colt & 511) + wc * 32 + 8 * fq;
#pragma unroll
                for (int bj = 0; bj < 2; ++bj) { const f32x4 v0 = acc[ai][bj][3][0], v1 = acc[ai][bj][3][1];
                    u32x4 w; w.x = cvt_pk_bf16(v0[0], v0[1]); w.y = cvt_pk_bf16(v0[2], v0[3]); w.z = cvt_pk_bf16(v1[0], v1[1]); w.w = cvt_pk_bf16(v1[2], v1[3]);
                    *(u32x4*)(hp + bj * HALF) = w; } }
        }
        if (t == 0) {
#pragma unroll
            for (int ai = 0; ai < 2; ++ai)
#pragma unroll
                for (int m = 0; m < 4; ++m)
#pragma unroll
                    for (int bj = 0; bj < 2; ++bj) { const f32x4 v0 = acc[ai][bj][m][0], v1 = acc[ai][bj][m][1];
                        float ss = (v0[0] * v0[0] + v0[1] * v0[1]) + (v0[2] * v0[2] + v0[3] * v0[3]) + (v1[0] * v1[0] + v1[1] * v1[1]) + (v1[2] * v1[2] + v1[3] * v1[3]);
                        ss = rows_sum(ss);
                        if (fq == 0) SSQ[(size_t)(row0 + ai * HALF + m * 16) * 16 + ((u.pn & 1) * 2 + bj) * 4 + wc] = ss; }
        }
    }
};
struct EpiZ {
    static constexpr bool PERM = true, AFTER_DRAIN = false, SEG = false;
    bf16_t* Oarr;
    __device__ __forceinline__ void operator()(const f32x4 (&acc)[2][2][4][2], const Unit& u, int wr, int wc, int fr, int fq) const {
        const int row0 = u.rb + wr * 64 + fr;
        bf16_t* base = Oarr + (size_t)(u.pn >> 1) * ((size_t)R * BW); const int col0 = (u.pn & 1) * 256 + wc * 32 + 8 * fq;
        u32x4 ol[2][4][2];
#pragma unroll
        for (int ai = 0; ai < 2; ++ai)
#pragma unroll
            for (int m = 0; m < 4; ++m)
#pragma unroll
                for (int bj = 0; bj < 2; ++bj) ol[ai][m][bj] = *(const u32x4*)(base + (size_t)(row0 + ai * HALF + m * 16) * BW + col0 + bj * HALF);
#pragma unroll
        for (int ai = 0; ai < 2; ++ai)
#pragma unroll
            for (int m = 0; m < 4; ++m) { bf16_t* rowp = base + (size_t)(row0 + ai * HALF + m * 16) * BW + col0;
#pragma unroll
                for (int bj = 0; bj < 2; ++bj) { const f32x4 v0 = acc[ai][bj][m][0], v1 = acc[ai][bj][m][1];
                    const u32x4 o = ol[ai][m][bj]; float z[8] = {v0[0], v0[1], v0[2], v0[3], v1[0], v1[1], v1[2], v1[3]};
                    float ov[8] = {bflo(o.x), bfhi(o.x), bflo(o.y), bfhi(o.y), bflo(o.z), bfhi(o.z), bflo(o.w), bfhi(o.w)};
#pragma unroll
                    for (int j = 0; j < 8; ++j) ov[j] = ov[j] * z[j] * sigmoidf_(z[j]);
                    u32x4 w; w.x = cvt_pk_bf16(ov[0], ov[1]); w.y = cvt_pk_bf16(ov[2], ov[3]); w.z = cvt_pk_bf16(ov[4], ov[5]); w.w = cvt_pk_bf16(ov[6], ov[7]);
                    *(u32x4*)(rowp + bj * HALF) = w; } }
    }
};
struct EpiMixU8 {
    static constexpr bool PERM = true, AFTER_DRAIN = false, SEG = false;
    unsigned char* MIX;
    __device__ __forceinline__ void operator()(const f32x4 (&acc)[2][2][4][2], const Unit& u, int wr, int wc, int fr, int fq) const {
        const int row0 = u.rb + wr * 64 + fr; const int mc = u.pn * 256;
        unsigned char* base = MIX + (size_t)(mc >> 10) * ((size_t)R * DM); const int col0 = (mc & 1023) + wc * 32 + 8 * fq;
#pragma unroll
        for (int ai = 0; ai < 2; ++ai)
#pragma unroll
            for (int m = 0; m < 4; ++m) { unsigned char* rowp = base + (size_t)(row0 + ai * HALF + m * 16) * DM + col0;
#pragma unroll
                for (int bj = 0; bj < 2; ++bj) { const f32x4 v0 = acc[ai][bj][m][0], v1 = acc[ai][bj][m][1]; unsigned q[8];
#pragma unroll
                    for (int j = 0; j < 4; ++j) { q[j] = (unsigned)(255.f * sigmoidf_(v0[j]) + 0.5f); q[4 + j] = (unsigned)(255.f * sigmoidf_(v1[j]) + 0.5f); q[j] = q[j] < 1u ? 1u : q[j]; q[4 + j] = q[4 + j] < 1u ? 1u : q[4 + j]; }
                    u32x2 w; w.x = q[0] | (q[1] << 8) | (q[2] << 16) | (q[3] << 24); w.y = q[4] | (q[5] << 8) | (q[6] << 16) | (q[7] << 24);
                    *(u32x2*)(rowp + bj * HALF) = w; } }
    }
};
struct EpiY {
    static constexpr bool PERM = true, AFTER_DRAIN = false, SEG = false;
    bf16_t* Y; const unsigned char* MIXb; int first;
    __device__ __forceinline__ void operator()(const f32x4 (&acc)[2][2][4][2], const Unit& u, int wr, int wc, int fr, int fq) const {
        const int row0 = u.rb + wr * 64 + fr; const int col0 = u.pn * BM + wc * 32 + 8 * fq;
#pragma unroll
        for (int ai = 0; ai < 2; ++ai)
#pragma unroll
            for (int m = 0; m < 4; ++m) { const size_t off = (size_t)(row0 + ai * HALF + m * 16) * DM + col0;
#pragma unroll
                for (int bj = 0; bj < 2; ++bj) { const f32x4 v0 = acc[ai][bj][m][0], v1 = acc[ai][bj][m][1];
                    const u32x2 g = *(const u32x2*)(MIXb + off + bj * HALF); constexpr float I255 = 1.f / 255.f;
                    float r[8] = {v0[0] * (float)(g.x & 255u) * I255, v0[1] * (float)((g.x >> 8) & 255u) * I255, v0[2] * (float)((g.x >> 16) & 255u) * I255, v0[3] * (float)(g.x >> 24) * I255,
                                  v1[0] * (float)(g.y & 255u) * I255, v1[1] * (float)((g.y >> 8) & 255u) * I255, v1[2] * (float)((g.y >> 16) & 255u) * I255, v1[3] * (float)(g.y >> 24) * I255};
                    if (!first) { const u32x4 y = *(const u32x4*)(Y + off + bj * HALF);
                        r[0] += bflo(y.x); r[1] += bfhi(y.x); r[2] += bflo(y.y); r[3] += bfhi(y.y); r[4] += bflo(y.z); r[5] += bfhi(y.z); r[6] += bflo(y.w); r[7] += bfhi(y.w); }
                    u32x4 w; w.x = cvt_pk_bf16(r[0], r[1]); w.y = cvt_pk_bf16(r[2], r[3]); w.z = cvt_pk_bf16(r[4], r[5]); w.w = cvt_pk_bf16(r[6], r[7]);
                    *(u32x4*)(Y + off + bj * HALF) = w; } }
    }
};
struct EpiYseg {
    static constexpr bool PERM = true, AFTER_DRAIN = false, SEG = true;
    bf16_t* Y; const unsigned char* MIX;
    __device__ __forceinline__ void seg_switch(f32x4 (&acc)[2][2][4][2], const Unit& u, int s, int wr, int wc, int fr, int fq) const {
        const int row0 = u.rb + wr * 64 + fr; const int col0 = u.pn * BM + wc * 32 + 8 * fq;
        const unsigned char* ga = MIX + (size_t)(s - 1) * R * DM; const unsigned char* gb = MIX + (size_t)s * R * DM;
#pragma unroll
        for (int ai = 0; ai < 2; ++ai) { u32x2 av[4][2], bv[4][2];
#pragma unroll
            for (int m = 0; m < 4; ++m) { const size_t off = (size_t)(row0 + ai * HALF + m * 16) * DM + col0;
#pragma unroll
                for (int bj = 0; bj < 2; ++bj) { av[m][bj] = *(const u32x2*)(ga + off + bj * HALF); bv[m][bj] = *(const u32x2*)(gb + off + bj * HALF); } }
            __builtin_amdgcn_sched_barrier(0);
#pragma unroll
            for (int m = 0; m < 4; ++m) {
#pragma unroll
                for (int bj = 0; bj < 2; ++bj) { const u32x2 a = av[m][bj], b = bv[m][bj];
#pragma unroll
                    for (int j = 0; j < 4; ++j) { acc[ai][bj][m][0][j] *= (float)((a.x >> (8 * j)) & 255u) * __builtin_amdgcn_rcpf((float)((b.x >> (8 * j)) & 255u));
                                                  acc[ai][bj][m][1][j] *= (float)((a.y >> (8 * j)) & 255u) * __builtin_amdgcn_rcpf((float)((b.y >> (8 * j)) & 255u)); } } } }
    }
    __device__ __forceinline__ void operator()(const f32x4 (&acc)[2][2][4][2], const Unit& u, int wr, int wc, int fr, int fq) const {
        const int row0 = u.rb + wr * 64 + fr; const int col0 = u.pn * BM + wc * 32 + 8 * fq; const unsigned char* gc = MIX + (size_t)2 * R * DM; constexpr float I255 = 1.f / 255.f;
        u32x2 gl[2][4][2];
#pragma unroll
        for (int ai = 0; ai < 2; ++ai)
#pragma unroll
            for (int m = 0; m < 4; ++m)
#pragma unroll
                for (int bj = 0; bj < 2; ++bj) gl[ai][m][bj] = *(const u32x2*)(gc + (size_t)(row0 + ai * HALF + m * 16) * DM + col0 + bj * HALF);
#pragma unroll
        for (int ai = 0; ai < 2; ++ai)
#pragma unroll
            for (int m = 0; m < 4; ++m) { const size_t off = (size_t)(row0 + ai * HALF + m * 16) * DM + col0;
#pragma unroll
                for (int bj = 0; bj < 2; ++bj) { const f32x4 v0 = acc[ai][bj][m][0], v1 = acc[ai][bj][m][1]; const u32x2 g = gl[ai][m][bj];
                    u32x4 w; w.x = cvt_pk_bf16(v0[0] * (float)(g.x & 255u) * I255, v0[1] * (float)((g.x >> 8) & 255u) * I255); w.y = cvt_pk_bf16(v0[2] * (float)((g.x >> 16) & 255u) * I255, v0[3] * (float)(g.x >> 24) * I255);
                    w.z = cvt_pk_bf16(v1[0] * (float)(g.y & 255u) * I255, v1[1] * (float)((g.y >> 8) & 255u) * I255); w.w = cvt_pk_bf16(v1[2] * (float)((g.y >> 16) & 255u) * I255, v1[3] * (float)(g.y >> 24) * I255);
                    *(u32x4*)(Y + off + bj * HALF) = w; } }
    }
};
struct EpiRes {
    static constexpr bool PERM = false, AFTER_DRAIN = false, SEG = false;
    float* in_front; float* in_big; float* out_front; float* out_big;
    __device__ __forceinline__ void operator()(const f32x4 (&acc)[2][2][4][2], const Unit& u, int wr, int wc, int fr, int fq) const {
        const int row0 = u.rb + wr * 64 + fr, col0 = u.pn * BM + wc * 32 + 4 * fq;
#pragma unroll
        for (int ai = 0; ai < 2; ++ai) { f32x4 hv[4][2][2];
#pragma unroll
            for (int m = 0; m < 4; ++m) { const float* ip = hrow(in_front, in_big, row0 + ai * HALF + m * 16) + col0;
#pragma unroll
                for (int bj = 0; bj < 2; ++bj)
#pragma unroll
                    for (int n = 0; n < 2; ++n) hv[m][bj][n] = *(const f32x4*)(ip + bj * HALF + n * 16); }
#pragma unroll
            for (int m = 0; m < 4; ++m) { float* op = hrow(out_front, out_big, row0 + ai * HALF + m * 16) + col0;
#pragma unroll
                for (int bj = 0; bj < 2; ++bj)
#pragma unroll
                    for (int n = 0; n < 2; ++n) *(f32x4*)(op + bj * HALF + n * 16) = hv[m][bj][n] + acc[ai][bj][m][n]; } }
    }
};
}

__device__ __forceinline__ void p0_transpose_item(const float* W, int ldw, int srccol0, bf16* WT, int K, int dstrow0, LAS float* scr, int k0, int lane) {
#pragma unroll 8
    for (int i = 0; i < 32; ++i) { const int kk = 2 * i + (lane >> 5); scr[kk * 33 + (lane & 31)] = W[(size_t)(k0 + kk) * ldw + srccol0 + (lane & 31)]; }
    LDS_WAIT(); asm volatile("" ::: "memory");
    const int c = lane & 7;
#pragma unroll
    for (int j = 0; j < 4; ++j) { const int n = (lane >> 3) + 8 * j; const LAS float* s = scr + (8 * c) * 33 + n;
        v4u o; o.x = pk2(s[0 * 33], s[1 * 33]); o.y = pk2(s[2 * 33], s[3 * 33]); o.z = pk2(s[4 * 33], s[5 * 33]); o.w = pk2(s[6 * 33], s[7 * 33]);
        *(v4u*)(WT + (size_t)(dstrow0 + n) * K + k0 + 8 * c) = o; }
    LDS_WAIT(); asm volatile("" ::: "memory");
}
__device__ __forceinline__ int in_src_col(int d) {
    if (d < 1024) return 512 + d;
    if (d < 2560) return 2048 + (d - 1024);
    if (d < 4096) return 4104 + (d - 2560);
    if (d < 4608) return d - 4096;
    if (d < 5120) return 1536 + (d - 4608);
    if (d < 5632) return 3584 + (d - 5120);
    if (d < 6144) return 5640 + (d - 5632);
    return 6152 + (d - 6144);
}

typedef short bf16x8 __attribute__((ext_vector_type(8)));
typedef short s16x4 __attribute__((ext_vector_type(4)));
typedef float f32x16 __attribute__((ext_vector_type(16)));
constexpr float LOG2E = 1.4426950408889634f;
constexpr float SB_THR = 160.f;
#define KSWZ(row, colB) ((row) * 256 + ((colB) ^ (((row) & 7) << 4)))
#define SBAR() __builtin_amdgcn_sched_barrier(0)
__device__ __forceinline__ int crow(int r, int hi) { return (r & 3) + 8 * (r >> 2) + 4 * hi; }
__device__ __forceinline__ unsigned cvtpk(float lo, float hi) { return pk2(lo, hi); }
__device__ __forceinline__ int v_st(int k, int c) { const int kk = (k & ~0xC) | ((k & 4) << 1) | ((k & 8) >> 1); return ((kk >> 3) * 4 + (c >> 5)) * 512 + ((kk & 7) * 32 + (c & 31)) * 2; }
__device__ __forceinline__ int v_rd_base(int lane) { return ((lane & 3) << 3) | (((lane >> 2) & 3) << 6) | (((lane >> 4) & 1) << 5) | (((lane >> 5) & 1) << 8); }
constexpr int v_rd_off(int d0, int ks, int half) { return d0 * 512 + ks * 4096 + half * 2048; }
template <int OFF> __device__ __forceinline__ s16x4 tr_read(int vb) {
    s16x4 r; asm volatile("ds_read_b64_tr_b16 %0, %1 offset:%2" : "=&v"(r) : "v"(vb), "i"(OFF) : "memory"); return r;
}
template <int D0> __device__ __forceinline__ void pv_one(f32x16& od, int vb, bf16x8 pa0, bf16x8 pa1, bf16x8 pa2, bf16x8 pa3) {
    const s16x4 l0 = tr_read<v_rd_off(D0, 0, 0)>(vb), h0 = tr_read<v_rd_off(D0, 0, 1)>(vb), l1 = tr_read<v_rd_off(D0, 1, 0)>(vb), h1 = tr_read<v_rd_off(D0, 1, 1)>(vb);
    const s16x4 l2 = tr_read<v_rd_off(D0, 2, 0)>(vb), h2 = tr_read<v_rd_off(D0, 2, 1)>(vb), l3 = tr_read<v_rd_off(D0, 3, 0)>(vb), h3 = tr_read<v_rd_off(D0, 3, 1)>(vb);
    asm volatile("s_waitcnt lgkmcnt(0)" ::: "memory"); SBAR();
#define PK(L, H) (bf16x8){L[0], L[1], L[2], L[3], H[0], H[1], H[2], H[3]}
    od = __builtin_amdgcn_mfma_f32_32x32x16_bf16(pa0, PK(l0, h0), od, 0, 0, 0);
    od = __builtin_amdgcn_mfma_f32_32x32x16_bf16(pa1, PK(l1, h1), od, 0, 0, 0);
    od = __builtin_amdgcn_mfma_f32_32x32x16_bf16(pa2, PK(l2, h2), od, 0, 0, 0);
    od = __builtin_amdgcn_mfma_f32_32x32x16_bf16(pa3, PK(l3, h3), od, 0, 0, 0);
#undef PK
}
__device__ __forceinline__ float permsum(float x) { auto rr = __builtin_amdgcn_permlane32_swap(__float_as_uint(x), __float_as_uint(x), false, false); return __uint_as_float(rr[0]) + __uint_as_float(rr[1]); }
__device__ __forceinline__ float permother(float x, int hi) { auto rr = __builtin_amdgcn_permlane32_swap(__float_as_uint(x), __float_as_uint(x), false, false); return hi ? __uint_as_float(rr[0]) : __uint_as_float(rr[1]); }

constexpr int SBL_QKT = 133120;
constexpr int SBL_V = 0, SBL_K = 32768, SBL_RK = 65536, SBL_FLAG = 65536 + 512, SBL_Q = 65536 + 1024;
template <bool MASKED>
__device__ __forceinline__ void sb_tile(f32x16 (&o)[4], float& run, const LAS unsigned char* ql, LAS unsigned char* Kl, LAS float* rkt, int vb, int r32, int hi, int kbase, int trow) {
    f32x16 p0 = {}, p1 = {};
#pragma unroll
    for (int d0 = 0; d0 < 8; ++d0) { const int cb = (d0 * 16 + hi * 8) * 2;
        const bf16x8 b0 = *(const LAS bf16x8*)(Kl + KSWZ(r32, cb)); const bf16x8 b1 = *(const LAS bf16x8*)(Kl + KSWZ(32 + r32, cb)); const bf16x8 qf = *(const LAS bf16x8*)(ql + d0 * 1024);
        p0 = __builtin_amdgcn_mfma_f32_32x32x16_bf16(b0, qf, p0, 0, 0, 0); p1 = __builtin_amdgcn_mfma_f32_32x32x16_bf16(b1, qf, p1, 0, 0, 0);
        if ((d0 & 1) == 1) SBAR(); }
    float z[32], tot[8], pt[8];
#pragma unroll
    for (int g = 0; g < 8; ++g) { const f32x4 rk = *(const LAS f32x4*)(rkt + (g >> 2) * 32 + (g & 3) * 8 + 4 * hi); float zz[4], s[4];
#pragma unroll
        for (int i = 0; i < 4; ++i) { const int r = (g & 3) * 4 + i; zz[i] = (g < 4 ? p0[r] : p1[r]) * rk[i];
            const float e = __builtin_amdgcn_exp2f(-fabsf(zz[i])); s[i] = fmaxf(zz[i], 0.f) + __builtin_amdgcn_logf(1.f + e);
            if (MASKED) { const int key = kbase + (g >> 2) * 32 + (g & 3) * 8 + 4 * hi + i; if (!(key < trow && key >= PADF)) s[i] = 0.f; } }
        s[2] += s[3]; s[1] += s[2]; s[0] += s[1]; tot[g] = s[0];
#pragma unroll
        for (int i = 0; i < 4; ++i) z[4 * g + i] = zz[i] - s[i]; }
#pragma unroll
    for (int g = 0; g < 8; ++g) pt[g] = permother(tot[g], hi);
    float E = run;
#pragma unroll
    for (int g = 7; g >= 0; --g) { const float off = E + (hi ? 0.f : pt[g]);
#pragma unroll
        for (int i = 0; i < 4; ++i) { float a = __builtin_amdgcn_exp2f(z[4 * g + i] - off);
            if (MASKED) { const int key = kbase + (g >> 2) * 32 + (g & 3) * 8 + 4 * hi + i; if (!(key < trow && key >= PADF)) a = 0.f; }
            z[4 * g + i] = a; }
        E += tot[g] + pt[g]; }
    run = E;
    bf16x8 pa0, pa1, pa2, pa3;
#define PK4(BASE, OUT) do { const unsigned a0 = cvtpk(z[BASE + 0], z[BASE + 1]), a1 = cvtpk(z[BASE + 2], z[BASE + 3]); \
        const unsigned b0_ = cvtpk(z[BASE + 4], z[BASE + 5]), b1_ = cvtpk(z[BASE + 6], z[BASE + 7]); \
        auto r0 = __builtin_amdgcn_permlane32_swap(a0, b0_, false, false); auto r1 = __builtin_amdgcn_permlane32_swap(a1, b1_, false, false); \
        v4u w = {r0[0], r1[0], r0[1], r1[1]}; OUT = __builtin_bit_cast(bf16x8, w); } while (0)
    PK4(0, pa0); PK4(8, pa1); PK4(16, pa2); PK4(24, pa3);
#undef PK4
    pv_one<0>(o[0], vb, pa0, pa1, pa2, pa3); pv_one<1>(o[1], vb, pa0, pa1, pa2, pa3); pv_one<2>(o[2], vb, pa0, pa1, pa2, pa3); pv_one<3>(o[3], vb, pa0, pa1, pa2, pa3);
}

template <bool DRY = false>
__device__ __forceinline__ void sb_unit(bf16* QO, const bf16* Kg, const bf16* Vg, const float* SSQ, int b, int h, int ui, LAS unsigned char* lds, int tid) {
    asm volatile("" : "+v"(tid));
    const int wid = __builtin_amdgcn_readfirstlane(tid >> 6), lane = tid & 63, r32 = lane & 31, hi = lane >> 5;
    const int T0 = 128 + 256 * ui; const size_t rb = (size_t)b * TP;
    LAS unsigned char* ql = lds + SBL_Q + wid * 8192 + lane * 16;
    const int jtop = T0 / 64 + 3, jhi = T0 / 64 + (wid >> 1);
    const int sr = tid >> 4, sc = (tid & 15) * 8, vst0 = v_st(sr, sc), vst1 = v_st(32 + sr, sc);
    LAS unsigned char* Vl = lds + SBL_V; LAS unsigned char* Kl = lds + SBL_K; LAS float* RK = (LAS float*)(lds + SBL_RK); volatile LAS int* FL = (volatile LAS int*)(lds + SBL_FLAG);
    const int vb0 = (int)(unsigned)(uintptr_t)Vl + v_rd_base(lane);
    v4u vs0, vs1, ks0, ks1; float sq;
#define SLOAD(j) do { const size_t r0_ = rb + (size_t)(j) * 64 + sr; vs0 = *(const v4u*)(Vg + r0_ * BW + h * HD + sc); vs1 = *(const v4u*)(Vg + (r0_ + 32) * BW + h * HD + sc); \
        ks0 = *(const v4u*)(Kg + r0_ * BW + h * HD + sc); ks1 = *(const v4u*)(Kg + (r0_ + 32) * BW + h * HD + sc); \
        sq = SSQ[(rb + (size_t)(j) * 64 + (tid & 63)) * 4 + h]; } while (0)
#define SWRITE(bf) do { *(LAS v4u*)(Vl + (bf) * 16384 + vst0) = vs0; *(LAS v4u*)(Vl + (bf) * 16384 + vst1) = vs1; \
        *(LAS v4u*)(Kl + (bf) * 16384 + KSWZ(sr, sc * 2)) = ks0; *(LAS v4u*)(Kl + (bf) * 16384 + KSWZ(32 + sr, sc * 2)) = ks1; \
        if (tid < 64) RK[(bf) * 64 + tid] = sq; } while (0)
    { const bf16* qp = QO + (rb + T0 + wid * 32 + r32) * BW + h * HD + hi * 8; v4u qw[8]; float ss = 0.f;
#pragma unroll
      for (int d0 = 0; d0 < 8; ++d0) qw[d0] = *(const v4u*)(qp + d0 * 16);
      SLOAD(jtop);
#pragma unroll
      for (int d0 = 0; d0 < 8; ++d0) { const v4u w = qw[d0];
          const float f0 = bflo(w.x), f1 = bfhi(w.x), f2 = bflo(w.y), f3 = bfhi(w.y), f4 = bflo(w.z), f5 = bfhi(w.z), f6 = bflo(w.w), f7 = bfhi(w.w);
          ss += (f0 * f0 + f1 * f1) + (f2 * f2 + f3 * f3) + (f4 * f4 + f5 * f5) + (f6 * f6 + f7 * f7); }
      ss = permsum(ss);
      const float rq = rsqrtf(ss * (1.f / HD) + EPS) * (QSCALE * LOG2E);
#pragma unroll
      for (int d0 = 0; d0 < 8; ++d0) { const int c0 = d0 * 16 + hi * 8; const f32x4 qa = *(const LAS f32x4*)(lds + SBL_QKT + c0 * 4), qb = *(const LAS f32x4*)(lds + SBL_QKT + c0 * 4 + 16);
          const v4u w0 = qw[d0]; v4u w;
          w.x = cvtpk(bflo(w0.x) * rq * qa[0], bfhi(w0.x) * rq * qa[1]); w.y = cvtpk(bflo(w0.y) * rq * qa[2], bfhi(w0.y) * rq * qa[3]);
          w.z = cvtpk(bflo(w0.z) * rq * qb[0], bfhi(w0.z) * rq * qb[1]); w.w = cvtpk(bflo(w0.w) * rq * qb[2], bfhi(w0.w) * rq * qb[3]);
          *(LAS v4u*)(ql + d0 * 1024) = w; } }
    f32x16 o[4] = {}; float run = 0.f; bool done = false;
    SWRITE(0); __syncthreads();
    int it = 0;
    for (int j = jtop; j >= 1; --j, ++it) {
        const int cur = it & 1;
        if (j > 1) SLOAD(j - 1);
        if (j <= jhi && !done) {
            const int trow = T0 + wid * 32 + r32;
            if (j == jhi || j == 1) sb_tile<true>(o, run, ql, Kl + cur * 16384, RK + cur * 64, vb0 + cur * 16384, r32, hi, j * 64, trow);
            else sb_tile<false>(o, run, ql, Kl + cur * 16384, RK + cur * 64, vb0 + cur * 16384, r32, hi, j * 64, trow);
            done = __all(run > SB_THR);
        }
        if (j > 1) SWRITE(cur ^ 1);
        if (lane == 0) FL[cur * 8 + wid] = done ? 1 : 0;
        __syncthreads();
        int all = 1;
#pragma unroll
        for (int w = 0; w < 8; ++w) all &= FL[cur * 8 + w];
        if (all) break;
    }
#undef SLOAD
#undef SWRITE
    { int t2 = tid; asm volatile("" : "+v"(t2)); const int lane = t2 & 63, r32 = lane & 31, hi = lane >> 5;
      LAS bf16* ot = (LAS bf16*)(lds + SBL_Q + wid * 8192);
#pragma unroll
      for (int r = 0; r < 16; ++r) { const int orow = crow(r, hi);
#pragma unroll
          for (int d0 = 0; d0 < 4; ++d0) ot[orow * 128 + d0 * 32 + r32] = (bf16)f2bf(o[d0][r]); }
      asm volatile("s_waitcnt lgkmcnt(0)" ::: "memory");
      bf16* op = QO + (rb + T0 + wid * 32) * BW + h * HD;
#pragma unroll
      for (int i = 0; i < 8; ++i) { const int pz = i * 64 + lane; const v4u w = *(const LAS v4u*)(lds + SBL_Q + wid * 8192 + pz * 16);
          if (!DRY) *(v4u*)(op + (size_t)(pz >> 4) * BW + (pz & 15) * 8) = w; else asm volatile("" :: "v"(w)); } }
    __syncthreads();
}

__device__ __forceinline__ int perm16(int c) { return (c & ~12) | ((c & 4) << 1) | ((c & 8) >> 1); }
constexpr int HL_QK = 0, HL_QK_STRIDE = 272;
constexpr int HL_AL = 60928, HL_AL_STRIDE = 144;
constexpr int HL_VT = HL_AL + 9216, HL_VT_STRIDE = 144;
constexpr int HL_ST = HL_VT + 18432;
constexpr int HL_RAW = HL_ST + 2048;
struct HgRaw { v4u q0, q1, f0, f1, i0, i1; };
__device__ __forceinline__ void hg_local_load(HgRaw& rw, const bf16* HQ, const bf16* HF, const bf16* HI, int b, int n, int h, int tid) {
    asm volatile("" : "+v"(tid));
    const size_t blk = ((size_t)b * TP + 64 * n) * BW + h * HD; const int row = tid >> 3, ch = (tid & 7) * 2; const size_t go = blk + (size_t)row * BW + ch * 8;
    rw.q0 = *(const v4u*)(HQ + go); rw.q1 = *(const v4u*)(HQ + go + 8); rw.f0 = *(const v4u*)(HF + go); rw.f1 = *(const v4u*)(HF + go + 8); rw.i0 = *(const v4u*)(HI + go); rw.i1 = *(const v4u*)(HI + go + 8);
}
template <bool DRY = false>
__device__ __forceinline__ void hg_local_item(const HgRaw& rw, bf16* HQ, bf16* HF, bf16* HI, bf16* OH, float* DEND, const float* lb, int b, int n, int h, LAS unsigned char* lds, int tid) {
    asm volatile("" : "+v"(tid));
    const int c = tid & 127, seg = __builtin_amdgcn_readfirstlane(tid >> 7), lane = tid & 63, wave = __builtin_amdgcn_readfirstlane(tid >> 6);
    const size_t blk = ((size_t)b * TP + 64 * n) * BW + h * HD;
    float qs[16], kk[16], vv[16], L[16];
    { const int row = tid >> 3, ch = (tid & 7) * 2;
      LAS unsigned char* rp = lds + HL_RAW + row * 256 + ch * 16;
      *(LAS v4u*)rp = rw.q0; *(LAS v4u*)(rp + 16) = rw.q1; *(LAS v4u*)(rp + 16384) = rw.f0; *(LAS v4u*)(rp + 16384 + 16) = rw.f1; *(LAS v4u*)(rp + 32768) = rw.i0; *(LAS v4u*)(rp + 32768 + 16) = rw.i1; }
    LDS_BARRIER();
    { const float l = lb[h * HD + c]; float run = 0.f; const LAS bf16* RW = (const LAS bf16*)(lds + HL_RAW);
#pragma unroll
      for (int i = 0; i < 16; ++i) { const int row = 16 * seg + i;
          const float q = bf2f(RW[row * 128 + c]), fp = bf2f(RW[8192 + row * 128 + c]), iv = bf2f(RW[16384 + row * 128 + c]);
          const float sg = sigmoidf_(fp); qs[i] = q * sigmoidf_(q); const float f = l + (1.f - l) * sg; kk[i] = (1.f - l) * (1.f - sg);
          run += __builtin_amdgcn_logf(f); L[i] = run; vv[i] = (64 * n + row >= PADF) ? iv : 0.f; } }
    LAS float* ST = (LAS float*)(lds + HL_ST);
    ST[seg * 128 + c] = L[15];
    { unsigned z0; asm volatile("v_mov_b32 %0, 0" : "=v"(z0)); for (int u = tid; u < 9216 / 16; u += 512) *(LAS v4u*)(lds + HL_AL + u * 16) = (v4u){z0, z0, z0, z0}; }
    LDS_BARRIER();
    const float st0 = ST[c], st1 = ST[128 + c], st2 = ST[256 + c], st3 = ST[384 + c];
    const float ref = (seg > 0 ? st0 : 0.f) + (seg > 1 ? st1 : 0.f) + (seg > 2 ? st2 : 0.f);
    const float aft = (seg < 1 ? st1 : 0.f) + (seg < 2 ? st2 : 0.f) + (seg < 3 ? st3 : 0.f);
    const float own = seg == 0 ? st0 : (seg == 1 ? st1 : (seg == 2 ? st2 : st3));
    { const int pc = perm16(c); unsigned kw[8], vw[8];
#pragma unroll
      for (int i = 0; i < 16; ++i) ((LAS bf16*)(lds + HL_RAW))[(16 * seg + i) * 128 + pc] = (bf16)f2bf(qs[i] * __builtin_amdgcn_exp2f(ref + L[i]));
#pragma unroll
      for (int i = 0; i < 8; ++i) { kw[i] = pk2(kk[2 * i] * __builtin_amdgcn_exp2f(aft + own - L[2 * i]), kk[2 * i + 1] * __builtin_amdgcn_exp2f(aft + own - L[2 * i + 1])); vw[i] = pk2(vv[2 * i], vv[2 * i + 1]); }
      const size_t toff = blk + (size_t)(c >> 1) * BW + (c & 1) * 64 + 16 * seg;
      if (!DRY) { *(v4u*)(HF + toff) = (v4u){kw[0], kw[1], kw[2], kw[3]}; *(v4u*)(HF + toff + 8) = (v4u){kw[4], kw[5], kw[6], kw[7]};
      *(v4u*)(HI + toff) = (v4u){vw[0], vw[1], vw[2], vw[3]}; *(v4u*)(HI + toff + 8) = (v4u){vw[4], vw[5], vw[6], vw[7]}; }
      else asm volatile("" :: "v"(kw[0]), "v"(kw[1]), "v"(kw[2]), "v"(kw[3]), "v"(kw[4]), "v"(kw[5]), "v"(kw[6]), "v"(kw[7]));
      *(LAS v4u*)(lds + HL_VT + c * HL_VT_STRIDE + 32 * seg) = (v4u){vw[0], vw[1], vw[2], vw[3]}; *(LAS v4u*)(lds + HL_VT + c * HL_VT_STRIDE + 32 * seg + 16) = (v4u){vw[4], vw[5], vw[6], vw[7]};
      if (!DRY && seg == 0) DEND[((size_t)(b * 4 + h) * NCH + n) * 128 + c] = __builtin_amdgcn_exp2f(st0 + st1 + st2 + st3); }
    { LAS bf16* QK = (LAS bf16*)(lds + HL_QK);
#pragma unroll
      for (int i = 0; i < 16; ++i) QK[(16 * seg + i) * (HL_QK_STRIDE / 2) + c] = (bf16)f2bf(qs[i] * __builtin_amdgcn_exp2f(L[i]));
#pragma unroll
      for (int I = 0; I < 4; ++I) { if (I < seg) continue;
          const float D = (I == seg) ? -own : ((seg < 1 && I > 1 ? st1 : 0.f) + (seg < 2 && I > 2 ? st2 : 0.f));
          const int koff = 64 + 8 * I * (I + 1) + 16 * seg;
#pragma unroll
          for (int i = 0; i < 16; ++i) QK[(koff + i) * (HL_QK_STRIDE / 2) + c] = (bf16)f2bf(kk[i] * __builtin_amdgcn_exp2f(D + own - L[i])); } }
    LDS_BARRIER();
    { const int row = tid >> 3, ch = (tid & 7) * 2; const v4u q0 = *(const LAS v4u*)(lds + HL_RAW + row * 256 + ch * 16), q1 = *(const LAS v4u*)(lds + HL_RAW + row * 256 + ch * 16 + 16);
      if (!DRY) { *(v4u*)(HQ + blk + (size_t)row * BW + ch * 8) = q0; *(v4u*)(HQ + blk + (size_t)row * BW + ch * 8 + 8) = q1; } else asm volatile("" :: "v"(q0), "v"(q1)); }
    { const int fr = lane & 15, fq = lane >> 4;
      for (int bi = wave; bi < 10; bi += 8) { const int I = bi < 1 ? 0 : (bi < 3 ? 1 : (bi < 6 ? 2 : 3)); const int J = bi - (I * (I + 1)) / 2;
          f32x4 acc = {0.f, 0.f, 0.f, 0.f};
#pragma unroll
          for (int ks = 0; ks < 4; ++ks) { const bf16x8 A = *(const LAS bf16x8*)(lds + HL_QK + (16 * I + fr) * HL_QK_STRIDE + (32 * ks + 8 * fq) * 2);
              const bf16x8 B = *(const LAS bf16x8*)(lds + HL_QK + (64 + 8 * I * (I + 1) + 16 * J + fr) * HL_QK_STRIDE + (32 * ks + 8 * fq) * 2);
              acc = __builtin_amdgcn_mfma_f32_16x16x32_bf16(A, B, acc, 0, 0, 0); }
          LAS bf16* AL = (LAS bf16*)(lds + HL_AL);
#pragma unroll
          for (int r = 0; r < 4; ++r) { const int i = 4 * fq + r; const float x = (I == J && fr > i) ? 0.f : acc[r]; AL[(16 * I + i) * (HL_AL_STRIDE / 2) + 16 * J + fr] = (bf16)f2bf(x); } } }
    LDS_BARRIER();
    { const int fr = lane & 15, fq = lane >> 4; const int col = 16 * wave + fr;
#pragma unroll
      for (int mt = 0; mt < 4; ++mt) { f32x4 acc = {0.f, 0.f, 0.f, 0.f};
#pragma unroll
          for (int ks = 0; ks < 2; ++ks) { const bf16x8 A = *(const LAS bf16x8*)(lds + HL_AL + (16 * mt + fr) * HL_AL_STRIDE + (32 * ks + 8 * fq) * 2);
              const bf16x8 B = *(const LAS bf16x8*)(lds + HL_VT + col * HL_VT_STRIDE + (32 * ks + 8 * fq) * 2);
              acc = __builtin_amdgcn_mfma_f32_16x16x32_bf16(A, B, acc, 0, 0, 0); }
          v2u w; w.x = pk2(acc[0], acc[1]); w.y = pk2(acc[2], acc[3]);
          if (!DRY) *(v2u*)(OH + blk + (size_t)(col >> 1) * BW + (col & 1) * 64 + 16 * mt + 4 * fq) = w; else asm volatile("" :: "v"(w.x), "v"(w.y)); } }
    LDS_BARRIER();
}

constexpr int HC_QE = 0, HC_QE_STRIDE = 272;
constexpr int HC_KET = 17408, HC_T_STRIDE = 144;
constexpr int HC_VT = HC_KET + 18432, HC_OIT = HC_VT + 18432;
constexpr int HC_DEND = HC_OIT + 18432;
constexpr int HC_OL = HC_DEND + 512, HC_OL_STRIDE = 132;
template <bool DRY = false>
__device__ __forceinline__ void hg_chain(const bf16* HQ, const bf16* HF, const bf16* HI, bf16* OH, const float* DEND, const float* onw, int b, int h, LAS unsigned char* lds, int tid) {
    asm volatile("" : "+v"(tid));
    const int wave = __builtin_amdgcn_readfirstlane(tid >> 6), lane = tid & 63, r32 = lane & 31, hi = lane >> 5;
    const int srow = tid >> 3, sch = (tid & 7) * 2;
    const size_t blk0 = ((size_t)b * TP) * BW + h * HD; const size_t soff = (size_t)srow * BW + sch * 8;
    const int ldq = srow * HC_QE_STRIDE + sch * 16, ldt = (2 * srow + (sch >> 3)) * HC_T_STRIDE + (sch & 7) * 16;
    const float* dend_c = DEND + (size_t)(b * 4 + h) * NCH * 128;
    v4u pf[8]; f32x4 pd;
#define HC_LOAD(n) do { const size_t o_ = blk0 + (size_t)(n) * 64 * BW + soff; pf[0] = *(const v4u*)(HQ + o_); pf[1] = *(const v4u*)(HQ + o_ + 8); pf[2] = *(const v4u*)(HF + o_); pf[3] = *(const v4u*)(HF + o_ + 8); \
        pf[4] = *(const v4u*)(HI + o_); pf[5] = *(const v4u*)(HI + o_ + 8); pf[6] = *(const v4u*)(OH + o_); pf[7] = *(const v4u*)(OH + o_ + 8); pd = *(const f32x4*)(dend_c + (size_t)(n) * 128 + 4 * (tid & 31)); } while (0)
#define HC_STORE() do { *(LAS v4u*)(lds + HC_QE + ldq) = pf[0]; *(LAS v4u*)(lds + HC_QE + ldq + 16) = pf[1]; *(LAS v4u*)(lds + HC_KET + ldt) = pf[2]; *(LAS v4u*)(lds + HC_KET + ldt + 16) = pf[3]; \
        *(LAS v4u*)(lds + HC_VT + ldt) = pf[4]; *(LAS v4u*)(lds + HC_VT + ldt + 16) = pf[5]; *(LAS v4u*)(lds + HC_OIT + ldt) = pf[6]; *(LAS v4u*)(lds + HC_OIT + ldt + 16) = pf[7]; \
        if (tid < 32) *(LAS f32x4*)(lds + HC_DEND + 16 * tid) = pd; } while (0)
    f32x16 sA[4] = {}; bf16x8 Sb[8];
#pragma unroll
    for (int k = 0; k < 8; ++k) Sb[k] = (bf16x8){0, 0, 0, 0, 0, 0, 0, 0};
    const int n0 = 32 * wave;
    const int ntok = tid >> 3, ncg = tid & 7;
    HC_LOAD(0); HC_STORE(); __syncthreads();
    for (int n = 0; n < NCH; ++n) {
        if (n + 1 < NCH) HC_LOAD(n + 1);
        if (wave < 4) {
            LAS float* OL = (LAS float*)(lds + HC_OL);
#pragma unroll
            for (int mt = 0; mt < 2; ++mt) { f32x16 acc;
#pragma unroll
                for (int g = 0; g < 4; ++g) { const v2u w = *(const LAS v2u*)(lds + HC_OIT + (n0 + r32) * HC_T_STRIDE + (32 * mt + 8 * g + 4 * hi) * 2);
                    acc[4 * g] = bflo(w.x); acc[4 * g + 1] = bfhi(w.x); acc[4 * g + 2] = bflo(w.y); acc[4 * g + 3] = bfhi(w.y); }
#pragma unroll
                for (int ks = 0; ks < 8; ++ks) { const bf16x8 A = *(const LAS bf16x8*)(lds + HC_QE + (32 * mt + r32) * HC_QE_STRIDE + (16 * ks + 8 * hi) * 2);
                    acc = __builtin_amdgcn_mfma_f32_32x32x16_bf16(A, Sb[ks], acc, 0, 0, 0); }
#pragma unroll
                for (int r = 0; r < 16; ++r) OL[(32 * mt + 8 * (r >> 2) + 4 * hi + (r & 3)) * HC_OL_STRIDE + n0 + r32] = acc[r]; }
#pragma unroll
            for (int mt = 0; mt < 4; ++mt) { f32x16 acc;
#pragma unroll
                for (int g = 0; g < 4; ++g) { const f32x4 dv = *(const LAS f32x4*)(lds + HC_DEND + (32 * mt + 8 * g + 4 * hi) * 4);
#pragma unroll
                    for (int i = 0; i < 4; ++i) acc[4 * g + i] = sA[mt][4 * g + i] * dv[i]; }
#pragma unroll
                for (int ks = 0; ks < 4; ++ks) { const bf16x8 A = *(const LAS bf16x8*)(lds + HC_KET + (32 * mt + r32) * HC_T_STRIDE + (16 * ks + 8 * hi) * 2);
                    const bf16x8 B = *(const LAS bf16x8*)(lds + HC_VT + (n0 + r32) * HC_T_STRIDE + (16 * ks + 8 * hi) * 2);
                    acc = __builtin_amdgcn_mfma_f32_32x32x16_bf16(A, B, acc, 0, 0, 0); }
                sA[mt] = acc; }
#pragma unroll
            for (int kt = 0; kt < 4; ++kt)
#pragma unroll
                for (int s2 = 0; s2 < 2; ++s2) { v4u w; w.x = cvtpk(sA[kt][8 * s2], sA[kt][8 * s2 + 1]); w.y = cvtpk(sA[kt][8 * s2 + 2], sA[kt][8 * s2 + 3]);
                    w.z = cvtpk(sA[kt][8 * s2 + 4], sA[kt][8 * s2 + 5]); w.w = cvtpk(sA[kt][8 * s2 + 6], sA[kt][8 * s2 + 7]); Sb[2 * kt + s2] = __builtin_bit_cast(bf16x8, w); }
        }
        __syncthreads();
        { const LAS float* OL = (const LAS float*)(lds + HC_OL) + ntok * HC_OL_STRIDE + 16 * ncg; f32x4 x[4]; float ss = 0.f;
#pragma unroll
          for (int j = 0; j < 4; ++j) { x[j] = *(const LAS f32x4*)(OL + 4 * j); ss += (x[j][0] * x[j][0] + x[j][1] * x[j][1]) + (x[j][2] * x[j][2] + x[j][3] * x[j][3]); }
          ss = red8(ss);
          const float rs = rsqrtf(ss * (1.f / HD) + EPS);
          f32x4 onv[4];
#pragma unroll
          for (int j = 0; j < 4; ++j) onv[j] = *(const f32x4*)(onw + 16 * ncg + 4 * j);
          v4u w0, w1; w0.x = pk2(x[0][0] * rs * onv[0][0], x[0][1] * rs * onv[0][1]); w0.y = pk2(x[0][2] * rs * onv[0][2], x[0][3] * rs * onv[0][3]); w0.z = pk2(x[1][0] * rs * onv[1][0], x[1][1] * rs * onv[1][1]); w0.w = pk2(x[1][2] * rs * onv[1][2], x[1][3] * rs * onv[1][3]);
          w1.x = pk2(x[2][0] * rs * onv[2][0], x[2][1] * rs * onv[2][1]); w1.y = pk2(x[2][2] * rs * onv[2][2], x[2][3] * rs * onv[2][3]); w1.z = pk2(x[3][0] * rs * onv[3][0], x[3][1] * rs * onv[3][1]); w1.w = pk2(x[3][2] * rs * onv[3][2], x[3][3] * rs * onv[3][3]);
          bf16* op = OH + blk0 + ((size_t)n * 64 + ntok) * BW + 16 * ncg; if (!DRY) { *(v4u*)op = w0; *(v4u*)(op + 8) = w1; } else asm volatile("" :: "v"(w0), "v"(w1)); }
        if (n + 1 < NCH) HC_STORE();
        __syncthreads();
    }
#undef HC_LOAD
#undef HC_STORE
}

typedef short s16x4v __attribute__((ext_vector_type(4)));
constexpr int GL_QL = 0, GL_KL = 17408, GL_STR = 272;
constexpr int GL_VF = 34816, GL_VF_STR = 132;
constexpr int GL_KK = GL_VF + 64 * 132 * 4;
constexpr int GL_QK = GL_KK + 16384;
constexpr int GL_NM = GL_QK + 16384, GL_NM_STR = 144;
constexpr int GL_DL = GL_NM + 9216;
constexpr int GL_SC = GL_DL + 2048;
struct GdnRaw { v4u raw[3][5]; float bt, g; };
__device__ __forceinline__ void gdn_local_load(GdnRaw& rw, const bf16* GQ, const bf16* GK, const bf16* GV, const bf16* HALO, const float* BETA, const float* GG, int b, int n, int h, int tid) {
    asm volatile("" : "+v"(tid));
    const size_t blk = ((size_t)b * TP + 64 * n) * BW + h * HD; const int gch = b * NCH + n; const int cg = tid & 15, rp = tid >> 4;
    { const size_t m_ = (size_t)b * TP + 64 * n + (tid & 63); rw.bt = BETA[m_ * 4 + h]; rw.g = GG[m_ * 4 + h]; }
#pragma unroll
    for (int which = 0; which < 3; ++which) { const bf16* src = which == 0 ? GQ : (which == 1 ? GK : GV);
#pragma unroll
        for (int i = 0; i < 5; ++i) { const int row = 2 * rp - 3 + i;
            if (row >= 0) rw.raw[which][i] = *(const v4u*)(src + blk + (size_t)row * BW + 8 * cg);
            else if (n > 0) rw.raw[which][i] = *(const v4u*)(HALO + (((size_t)which * (R / 64) + gch - 1) * 3 + (3 + row)) * BW + h * HD + 8 * cg);
            else { unsigned z0; asm volatile("v_mov_b32 %0, 0" : "=v"(z0)); rw.raw[which][i] = (v4u){z0, z0, z0, z0}; } } }
}
template <bool DRY = false, int STEPS = 9>
__device__ __forceinline__ void gdn_local_item(const GdnRaw& rw, bf16* GQ, bf16* GK, bf16* GV, bf16* OW, bf16* AQK, float* GLp, const float* convw,
                                               int b, int n, int h, LAS unsigned char* lds, int tid) {
    asm volatile("" : "+v"(tid));
    const int c = tid & 127, seg = __builtin_amdgcn_readfirstlane(tid >> 7), lane = tid & 63, wave = __builtin_amdgcn_readfirstlane(tid >> 6), fr = lane & 15, fq = lane >> 4;
    const size_t blk = ((size_t)b * TP + 64 * n) * BW + h * HD;
    LAS float* SC = (LAS float*)(lds + GL_SC);
    const float bt_early = rw.bt, g_early = rw.g;
    { const int cg = tid & 15, rp = tid >> 4;
#pragma unroll
      for (int which = 0; which < 3; ++which) {
          f32x4 wv[4][2];
#pragma unroll
          for (int i = 0; i < 4; ++i) { wv[i][0] = *(const f32x4*)(convw + i * 1536 + which * 512 + h * HD + 8 * cg); wv[i][1] = *(const f32x4*)(convw + i * 1536 + which * 512 + h * HD + 8 * cg + 4); }
#pragma unroll
          for (int rr = 0; rr < 2; ++rr) { float y[8];
#pragma unroll
              for (int j = 0; j < 8; ++j) y[j] = 0.f;
#pragma unroll
              for (int i = 0; i < 4; ++i) { const v4u w = rw.raw[which][rr + i]; const float x[8] = {bflo(w.x), bfhi(w.x), bflo(w.y), bfhi(w.y), bflo(w.z), bfhi(w.z), bflo(w.w), bfhi(w.w)};
#pragma unroll
                  for (int j = 0; j < 8; ++j) y[j] += x[j] * wv[i][j >> 2][j & 3]; }
#pragma unroll
              for (int j = 0; j < 8; ++j) y[j] = y[j] * sigmoidf_(y[j]);
              const int row = 2 * rp + rr;
              if (which < 2) *(LAS v4u*)(lds + (which == 0 ? GL_QL : GL_KL) + row * GL_STR + 16 * cg) = (v4u){pk2(y[0], y[1]), pk2(y[2], y[3]), pk2(y[4], y[5]), pk2(y[6], y[7])};
              else { LAS float* vp = (LAS float*)(lds + GL_VF) + row * GL_VF_STR + 8 * cg; *(LAS f32x4*)vp = (f32x4){y[0], y[1], y[2], y[3]}; *(LAS f32x4*)(vp + 4) = (f32x4){y[4], y[5], y[6], y[7]}; } } } }
    LDS_BARRIER();
    if (STEPS <= 1) { LDS_BARRIER(); return; }
    for (int job = wave; job < 24; job += 8) { const int kind = job < 10 ? 0 : (job < 20 ? 1 : 2); const int bi = job < 10 ? job : (job < 20 ? job - 10 : 0);
        int I = bi < 1 ? 0 : (bi < 3 ? 1 : (bi < 6 ? 2 : 3)); int J = bi - (I * (I + 1)) / 2; if (kind == 2) { I = job - 20; J = I; }
        const int abase = kind == 0 ? GL_KL : GL_QL, bbase = kind == 2 ? GL_QL : GL_KL;
        f32x4 acc = {0.f, 0.f, 0.f, 0.f};
#pragma unroll
        for (int ks = 0; ks < 4; ++ks) { const bf16x8 A = *(const LAS bf16x8*)(lds + abase + (16 * I + fr) * GL_STR + (32 * ks + 8 * fq) * 2);
            const bf16x8 B = *(const LAS bf16x8*)(lds + bbase + (16 * J + fr) * GL_STR + (32 * ks + 8 * fq) * 2);
            acc = __builtin_amdgcn_mfma_f32_16x16x32_bf16(A, B, acc, 0, 0, 0); }
        if (kind < 2) { LAS float* D = (LAS float*)(lds + (kind == 0 ? GL_KK : GL_QK));
#pragma unroll
            for (int r = 0; r < 4; ++r) D[(16 * I + 4 * fq + r) * 64 + 16 * J + fr] = acc[r]; }
        if (kind != 1 && I == J) {
#pragma unroll
            for (int r = 0; r < 4; ++r) if (fr == 4 * fq + r) SC[(kind == 0 ? 0 : 64) + 16 * I + fr] = acc[r]; } }
    LDS_BARRIER();
    if (STEPS <= 2) { LDS_BARRIER(); return; }
    if (tid < 64) {
        SC[128 + tid] = rsqrtf(SC[tid] + EPS); SC[192 + tid] = rsqrtf(SC[64 + tid] + EPS) * QSCALE; SC[256 + tid] = bt_early;
        float gc = g_early;
#pragma unroll
        for (int d = 1; d < 64; d <<= 1) { const float o = __uint_as_float((unsigned)__builtin_amdgcn_ds_bpermute((tid - d) << 2, (int)__float_as_uint(gc))); gc += (tid >= d) ? o : 0.f; }
        SC[320 + tid] = gc * LOG2E; }
    LDS_BARRIER();
    if (STEPS <= 3) { LDS_BARRIER(); return; }
    { const int i = tid >> 3, jg = tid & 7; const float rki = SC[128 + i], rqi = SC[192 + i], bti = SC[256 + i], gci = SC[320 + i];
      float mv[8], av[8];
#pragma unroll
      for (int jj = 0; jj < 8; ++jj) { const int j = 8 * jg + jj; const float rkj = SC[128 + j], dec = __builtin_amdgcn_exp2f(fminf(gci - SC[320 + j], 0.f));
          const float kkv = ((const LAS float*)(lds + GL_KK))[i * 64 + j], qkv = ((const LAS float*)(lds + GL_QK))[i * 64 + j];
          mv[jj] = (j < i) ? -(bti * kkv * rki * rkj * dec) : 0.f; av[jj] = (j <= i) ? qkv * rqi * rkj * dec : 0.f; }
      *(LAS v4u*)(lds + GL_NM + i * GL_NM_STR + 16 * jg) = (v4u){pk2(mv[0], mv[1]), pk2(mv[2], mv[3]), pk2(mv[4], mv[5]), pk2(mv[6], mv[7])};
      bf16* ap = AQK + ((size_t)b * TP + 64 * n + i) * 256 + h * 64 + (jg >> 1) * 16 + (jg & 1) * 4;
      const v2u a0_ = (v2u){pk2(av[0], av[1]), pk2(av[2], av[3])}, a1_ = (v2u){pk2(av[4], av[5]), pk2(av[6], av[7])};
      if (!DRY) { *(v2u*)ap = a0_; *(v2u*)(ap + 8) = a1_; } else asm volatile("" :: "v"(a0_.x), "v"(a0_.y), "v"(a1_.x), "v"(a1_.y)); }
    LDS_BARRIER();
    if (STEPS <= 4) { LDS_BARRIER(); return; }
    if (wave == 0) { const int bb = lane >> 4, col = lane & 15; float x[16];
#pragma unroll
        for (int i = 0; i < 16; ++i) { float a = (i == col) ? 1.f : 0.f; const LAS bf16* mr = (const LAS bf16*)(lds + GL_NM + (16 * bb + i) * GL_NM_STR) + 16 * bb;
#pragma unroll
            for (int j = 0; j < 16; ++j) if (j < i) a += bf2f(mr[j]) * x[j];
            x[i] = a; }
#pragma unroll
        for (int i = 0; i < 16; ++i) ((LAS bf16*)(lds + GL_DL))[(bb * 16 + i) * 16 + col] = (bf16)f2bf(x[i]); }
    LDS_BARRIER();
    if (STEPS <= 5) { LDS_BARRIER(); return; }
#pragma unroll
    for (int tt = 0; tt < 2; ++tt) { const int ct = 2 * wave + tt; const bool isU = ct < 8; const int col = 16 * (ct & 7) + fr;
        s16x4v Xb[4];
#pragma unroll
        for (int bb = 0; bb < 4; ++bb) { f32x4 acc;
#pragma unroll
            for (int r = 0; r < 4; ++r) { const int row = 16 * bb + 4 * fq + r; const float bt = SC[256 + row];
                acc[r] = isU ? bt * ((const LAS float*)(lds + GL_VF))[row * GL_VF_STR + col]
                             : bt * __builtin_amdgcn_exp2f(SC[320 + row]) * SC[128 + row] * bf2f(((const LAS bf16*)(lds + GL_KL))[row * (GL_STR / 2) + col]); }
#pragma unroll
            for (int cc = 0; cc < 4; ++cc) if (cc < bb) { const s16x4v A = *(const LAS s16x4v*)(lds + GL_NM + (16 * bb + fr) * GL_NM_STR + (16 * cc + 4 * fq) * 2);
                acc = __builtin_amdgcn_mfma_f32_16x16x16bf16_1k(A, Xb[cc], acc, 0, 0, 0); }
            const s16x4v Dg = *(const LAS s16x4v*)(lds + GL_DL + ((bb * 16 + fr) * 16 + 4 * fq) * 2);
            v2u aw; aw.x = pk2(acc[0], acc[1]); aw.y = pk2(acc[2], acc[3]);
            f32x4 X = {0.f, 0.f, 0.f, 0.f}; X = __builtin_amdgcn_mfma_f32_16x16x16bf16_1k(Dg, __builtin_bit_cast(s16x4v, aw), X, 0, 0, 0);
            v2u xw; xw.x = pk2(X[0], X[1]); xw.y = pk2(X[2], X[3]); Xb[bb] = __builtin_bit_cast(s16x4v, xw);
            if (DRY) asm volatile("" :: "v"(xw.x), "v"(xw.y));
            else if (isU) *(v2u*)(GV + blk + (size_t)(col >> 1) * BW + (col & 1) * 64 + 16 * bb + 4 * fq) = xw;
            else { const int pc = perm16(col);
#pragma unroll
                for (int r = 0; r < 4; ++r) ((LAS bf16*)(lds + GL_KK))[(16 * bb + 4 * fq + r) * 128 + pc] = (bf16)f2bf(-X[r]); } } }
    if (STEPS <= 6) { LDS_BARRIER(); return; }
    { const int pc = perm16(c); const float gl = SC[320 + 63]; unsigned kw[8]; float kd[16];
#pragma unroll
      for (int i = 0; i < 16; ++i) { const int row = 16 * seg + i; const float gc = SC[320 + row];
          const float qv = bf2f(((const LAS bf16*)(lds + GL_QL))[row * (GL_STR / 2) + c]), kv = bf2f(((const LAS bf16*)(lds + GL_KL))[row * (GL_STR / 2) + c]);
          ((LAS bf16*)(lds + GL_QK))[row * 128 + pc] = (bf16)f2bf(qv * SC[192 + row] * __builtin_amdgcn_exp2f(gc));
          kd[i] = kv * SC[128 + row] * __builtin_amdgcn_exp2f(gl - gc); }
      kw[0] = pk2(kd[0], kd[1]); kw[1] = pk2(kd[2], kd[3]); kw[2] = pk2(kd[8], kd[9]); kw[3] = pk2(kd[10], kd[11]); kw[4] = pk2(kd[4], kd[5]); kw[5] = pk2(kd[6], kd[7]); kw[6] = pk2(kd[12], kd[13]); kw[7] = pk2(kd[14], kd[15]);
      const size_t toff = blk + (size_t)(c >> 1) * BW + (c & 1) * 64 + 16 * seg;
      if (!DRY) { *(v4u*)(GK + toff) = (v4u){kw[0], kw[1], kw[2], kw[3]}; *(v4u*)(GK + toff + 8) = (v4u){kw[4], kw[5], kw[6], kw[7]}; }
      else asm volatile("" :: "v"(kw[0]), "v"(kw[1]), "v"(kw[2]), "v"(kw[3]), "v"(kw[4]), "v"(kw[5]), "v"(kw[6]), "v"(kw[7]));
      if (!DRY && tid == 0) GLp[(size_t)(b * 4 + h) * NCH + n] = __builtin_amdgcn_exp2f(gl); }
    LDS_BARRIER();
    { const int row = tid >> 3, ch = (tid & 7) * 2; const size_t go = blk + (size_t)row * BW + ch * 8;
      const v4u q0 = *(const LAS v4u*)(lds + GL_QK + row * 256 + ch * 16), q1 = *(const LAS v4u*)(lds + GL_QK + row * 256 + ch * 16 + 16);
      const v4u w0 = *(const LAS v4u*)(lds + GL_KK + row * 256 + ch * 16), w1 = *(const LAS v4u*)(lds + GL_KK + row * 256 + ch * 16 + 16);
      if (!DRY) { *(v4u*)(GQ + go) = q0; *(v4u*)(GQ + go + 8) = q1; *(v4u*)(OW + go) = w0; *(v4u*)(OW + go + 8) = w1; }
      else asm volatile("" :: "v"(q0), "v"(q1), "v"(w0), "v"(w1)); }
    LDS_BARRIER();
}

constexpr int GC_NW = 0, GC_QD = 17408, GC_STR = 272;
constexpr int GC_UT = 34816, GC_KDT = GC_UT + 18432, GC_TSTR = 144;
constexpr int GC_AQ = GC_KDT + 18432;
constexpr int GC_GLW = GC_AQ + 9216;
constexpr int GC_OL = GC_GLW + 16, GC_OL_STRIDE = 132;
template <bool DRY = false>
__device__ __forceinline__ void gdn_chain(const bf16* GQ, const bf16* GK, const bf16* GV, bf16* OW, const bf16* AQK, const float* GLp, const float* onw, int b, int h, LAS unsigned char* lds, int tid) {
    asm volatile("" : "+v"(tid));
    const int wave = __builtin_amdgcn_readfirstlane(tid >> 6), lane = tid & 63, r32 = lane & 31, hi = lane >> 5;
    const int srow = tid >> 3, sch = (tid & 7) * 2;
    const size_t blk0 = ((size_t)b * TP) * BW + h * HD; const size_t soff = (size_t)srow * BW + sch * 8;
    const int ldq = srow * GC_STR + sch * 16, ldt = (2 * srow + (sch >> 3)) * GC_TSTR + (sch & 7) * 16;
    const size_t aq0 = ((size_t)b * TP) * 256 + h * 64 + (size_t)srow * 256 + (tid & 7) * 8; const int lda = srow * GC_TSTR + (tid & 7) * 16;
    const float* gl_c = GLp + (size_t)(b * 4 + h) * NCH;
    v4u pf[9]; float pg;
#define GC_LOAD(n) do { const size_t o_ = blk0 + (size_t)(n) * 64 * BW + soff; pf[0] = *(const v4u*)(OW + o_); pf[1] = *(const v4u*)(OW + o_ + 8); pf[2] = *(const v4u*)(GQ + o_); pf[3] = *(const v4u*)(GQ + o_ + 8); \
        pf[4] = *(const v4u*)(GV + o_); pf[5] = *(const v4u*)(GV + o_ + 8); pf[6] = *(const v4u*)(GK + o_); pf[7] = *(const v4u*)(GK + o_ + 8); pf[8] = *(const v4u*)(AQK + aq0 + (size_t)(n) * 64 * 256); pg = __hip_atomic_load(gl_c + (n), __ATOMIC_RELAXED, __HIP_MEMORY_SCOPE_AGENT); } while (0)
#define GC_STORE() do { *(LAS v4u*)(lds + GC_NW + ldq) = pf[0]; *(LAS v4u*)(lds + GC_NW + ldq + 16) = pf[1]; *(LAS v4u*)(lds + GC_QD + ldq) = pf[2]; *(LAS v4u*)(lds + GC_QD + ldq + 16) = pf[3]; \
        *(LAS v4u*)(lds + GC_UT + ldt) = pf[4]; *(LAS v4u*)(lds + GC_UT + ldt + 16) = pf[5]; *(LAS v4u*)(lds + GC_KDT + ldt) = pf[6]; *(LAS v4u*)(lds + GC_KDT + ldt + 16) = pf[7]; \
        *(LAS v4u*)(lds + GC_AQ + lda) = pf[8]; if (tid == 0) *(LAS float*)(lds + GC_GLW) = pg; } while (0)
    f32x16 sA[4] = {}; bf16x8 Sb[8];
#pragma unroll
    for (int k = 0; k < 8; ++k) Sb[k] = (bf16x8){0, 0, 0, 0, 0, 0, 0, 0};
    const int n0 = 32 * wave; const int ntok = tid >> 3, ncg = tid & 7;
    GC_LOAD(0); GC_STORE(); __syncthreads();
    for (int n = 0; n < NCH; ++n) {
        if (n + 1 < NCH) GC_LOAD(n + 1);
        if (wave < 4) {
            LAS float* OL = (LAS float*)(lds + GC_OL); const float gl = *(const LAS float*)(lds + GC_GLW);
            bf16x8 Vb[4];
#pragma unroll
            for (int mt = 0; mt < 2; ++mt) { f32x16 acc;
#pragma unroll
                for (int g = 0; g < 4; ++g) { const v2u w = *(const LAS v2u*)(lds + GC_UT + (n0 + r32) * GC_TSTR + (32 * mt + 8 * g + 4 * hi) * 2);
                    acc[4 * g] = bflo(w.x); acc[4 * g + 1] = bfhi(w.x); acc[4 * g + 2] = bflo(w.y); acc[4 * g + 3] = bfhi(w.y); }
#pragma unroll
                for (int ks = 0; ks < 8; ++ks) { const bf16x8 A = *(const LAS bf16x8*)(lds + GC_NW + (32 * mt + r32) * GC_STR + (16 * ks + 8 * hi) * 2);
                    acc = __builtin_amdgcn_mfma_f32_32x32x16_bf16(A, Sb[ks], acc, 0, 0, 0); }
#pragma unroll
                for (int s2 = 0; s2 < 2; ++s2) { v4u w; w.x = cvtpk(acc[8 * s2], acc[8 * s2 + 1]); w.y = cvtpk(acc[8 * s2 + 2], acc[8 * s2 + 3]); w.z = cvtpk(acc[8 * s2 + 4], acc[8 * s2 + 5]); w.w = cvtpk(acc[8 * s2 + 6], acc[8 * s2 + 7]);
                    Vb[2 * mt + s2] = __builtin_bit_cast(bf16x8, w); } }
#pragma unroll
            for (int mt = 0; mt < 2; ++mt) { f32x16 acc = {};
#pragma unroll
                for (int ks = 0; ks < 8; ++ks) { const bf16x8 A = *(const LAS bf16x8*)(lds + GC_QD + (32 * mt + r32) * GC_STR + (16 * ks + 8 * hi) * 2);
                    acc = __builtin_amdgcn_mfma_f32_32x32x16_bf16(A, Sb[ks], acc, 0, 0, 0); }
#pragma unroll
                for (int ks = 0; ks < 4; ++ks) { const bf16x8 A = *(const LAS bf16x8*)(lds + GC_AQ + (32 * mt + r32) * GC_TSTR + (16 * ks + 8 * hi) * 2);
                    acc = __builtin_amdgcn_mfma_f32_32x32x16_bf16(A, Vb[ks], acc, 0, 0, 0); }
#pragma unroll
                for (int r = 0; r < 16; ++r) OL[(32 * mt + 8 * (r >> 2) + 4 * hi + (r & 3)) * GC_OL_STRIDE + n0 + r32] = acc[r]; }
#pragma unroll
            for (int mt = 0; mt < 4; ++mt) { f32x16 acc;
#pragma unroll
                for (int r = 0; r < 16; ++r) acc[r] = sA[mt][r] * gl;
#pragma unroll
                for (int ks = 0; ks < 4; ++ks) { const bf16x8 A = *(const LAS bf16x8*)(lds + GC_KDT + (32 * mt + r32) * GC_TSTR + (16 * ks + 8 * hi) * 2);
                    acc = __builtin_amdgcn_mfma_f32_32x32x16_bf16(A, Vb[ks], acc, 0, 0, 0); }
                sA[mt] = acc; }
#pragma unroll
            for (int kt = 0; kt < 4; ++kt)
#pragma unroll
                for (int s2 = 0; s2 < 2; ++s2) { v4u w; w.x = cvtpk(sA[kt][8 * s2], sA[kt][8 * s2 + 1]); w.y = cvtpk(sA[kt][8 * s2 + 2], sA[kt][8 * s2 + 3]);
                    w.z = cvtpk(sA[kt][8 * s2 + 4], sA[kt][8 * s2 + 5]); w.w = cvtpk(sA[kt][8 * s2 + 6], sA[kt][8 * s2 + 7]); Sb[2 * kt + s2] = __builtin_bit_cast(bf16x8, w); }
        }
        __syncthreads();
        { const LAS float* OL = (const LAS float*)(lds + GC_OL) + ntok * GC_OL_STRIDE + 16 * ncg; f32x4 x[4]; float ss = 0.f;
#pragma unroll
          for (int j = 0; j < 4; ++j) { x[j] = *(const LAS f32x4*)(OL + 4 * j); ss += (x[j][0] * x[j][0] + x[j][1] * x[j][1]) + (x[j][2] * x[j][2] + x[j][3] * x[j][3]); }
          ss = red8(ss);
          const float rs = rsqrtf(ss * (1.f / HD) + EPS);
          f32x4 onv[4];
#pragma unroll
          for (int j = 0; j < 4; ++j) onv[j] = *(const f32x4*)(onw + 16 * ncg + 4 * j);
          v4u w0, w1; w0.x = pk2(x[0][0] * rs * onv[0][0], x[0][1] * rs * onv[0][1]); w0.y = pk2(x[0][2] * rs * onv[0][2], x[0][3] * rs * onv[0][3]); w0.z = pk2(x[1][0] * rs * onv[1][0], x[1][1] * rs * onv[1][1]); w0.w = pk2(x[1][2] * rs * onv[1][2], x[1][3] * rs * onv[1][3]);
          w1.x = pk2(x[2][0] * rs * onv[2][0], x[2][1] * rs * onv[2][1]); w1.y = pk2(x[2][2] * rs * onv[2][2], x[2][3] * rs * onv[2][3]); w1.z = pk2(x[3][0] * rs * onv[3][0], x[3][1] * rs * onv[3][1]); w1.w = pk2(x[3][2] * rs * onv[3][2], x[3][3] * rs * onv[3][3]);
          bf16* op = OW + blk0 + ((size_t)n * 64 + ntok) * BW + 16 * ncg; if (!DRY) { *(v4u*)op = w0; *(v4u*)(op + 8) = w1; } else asm volatile("" :: "v"(w0), "v"(w1)); }
        if (n + 1 < NCH) GC_STORE();
        __syncthreads();
    }
#undef GC_LOAD
#undef GC_STORE
}

constexpr int C2_ONW = 146688;
constexpr int H2_QE = 0, H2_KET = 17408, H2_VT = 35840, H2_OIT = 54272, H2_DEND = 72704, H2_OL = 73216, H2_XS = 107008;
template <int MH>
__device__ __forceinline__ void hg2_compute(LAS unsigned char* lds, f32x16 (&sA)[2], bf16x8 (&Sb)[8], int n0, int r32, int hi, int wave, int lane) {
    LAS float* OL = (LAS float*)(lds + H2_OL);
    { f32x16 acc;
#pragma unroll
      for (int g = 0; g < 4; ++g) { const v2u w = *(const LAS v2u*)(lds + H2_OIT + (n0 + r32) * 144 + (32 * MH + 8 * g + 4 * hi) * 2);
          acc[4 * g] = bflo(w.x); acc[4 * g + 1] = bfhi(w.x); acc[4 * g + 2] = bflo(w.y); acc[4 * g + 3] = bfhi(w.y); }
#pragma unroll
      for (int ks = 0; ks < 8; ++ks) { const bf16x8 A = *(const LAS bf16x8*)(lds + H2_QE + (32 * MH + r32) * 272 + (16 * ks + 8 * hi) * 2); acc = __builtin_amdgcn_mfma_f32_32x32x16_bf16(A, Sb[ks], acc, 0, 0, 0); }
#pragma unroll
      for (int r = 0; r < 16; ++r) OL[(32 * MH + 8 * (r >> 2) + 4 * hi + (r & 3)) * 132 + n0 + r32] = acc[r]; }
    bf16x8 Vf[4];
#pragma unroll
    for (int ks = 0; ks < 4; ++ks) Vf[ks] = *(const LAS bf16x8*)(lds + H2_VT + (n0 + r32) * 144 + (16 * ks + 8 * hi) * 2);
#pragma unroll
    for (int t = 0; t < 2; ++t) { const int mt = 2 * MH + t; f32x16 acc;
#pragma unroll
        for (int g = 0; g < 4; ++g) { const f32x4 dv = *(const LAS f32x4*)(lds + H2_DEND + (32 * mt + 8 * g + 4 * hi) * 4);
#pragma unroll
            for (int i = 0; i < 4; ++i) acc[4 * g + i] = sA[t][4 * g + i] * dv[i]; }
#pragma unroll
        for (int ks = 0; ks < 4; ++ks) { const bf16x8 A = *(const LAS bf16x8*)(lds + H2_KET + (32 * mt + r32) * 144 + (16 * ks + 8 * hi) * 2); acc = __builtin_amdgcn_mfma_f32_32x32x16_bf16(A, Vf[ks], acc, 0, 0, 0); }
        sA[t] = acc;
#pragma unroll
        for (int s2 = 0; s2 < 2; ++s2) { v4u w; w.x = cvtpk(acc[8 * s2], acc[8 * s2 + 1]); w.y = cvtpk(acc[8 * s2 + 2], acc[8 * s2 + 3]); w.z = cvtpk(acc[8 * s2 + 4], acc[8 * s2 + 5]); w.w = cvtpk(acc[8 * s2 + 6], acc[8 * s2 + 7]);
            Sb[4 * MH + 2 * t + s2] = __builtin_bit_cast(bf16x8, w); *(LAS v4u*)(lds + H2_XS + wave * 4096 + (2 * t + s2) * 1024 + lane * 16) = w; } }
}
template <bool DRY = false>
__device__ __forceinline__ void hg_chain2(const bf16* HQ, const bf16* HF, const bf16* HI, bf16* OH, const float* DEND, const float* onw, int b, int h, LAS unsigned char* lds, int tid, int nb, int ne, bool first) {
    asm volatile("" : "+v"(tid));
    const int wave = __builtin_amdgcn_readfirstlane(tid >> 6), lane = tid & 63, r32 = lane & 31, hi = lane >> 5, mh = wave >> 2, n0 = 32 * (wave & 3);
    const int srow = tid >> 3, sch = (tid & 7) * 2;
    const size_t blk0 = ((size_t)b * TP) * BW + h * HD; const size_t soff = (size_t)srow * BW + sch * 8;
    const int ldq = srow * 272 + sch * 16, ldt = (2 * srow + (sch >> 3)) * 144 + (sch & 7) * 16;
    const float* dend_c = DEND + (size_t)(b * 4 + h) * NCH * 128;
    v4u pf[8]; f32x4 pd;
#define H2_LOAD(n) do { const size_t o_ = blk0 + (size_t)(n) * 64 * BW + soff; pf[0] = *(const v4u*)(HQ + o_); pf[1] = *(const v4u*)(HQ + o_ + 8); pf[2] = *(const v4u*)(HF + o_); pf[3] = *(const v4u*)(HF + o_ + 8); \
        pf[4] = *(const v4u*)(HI + o_); pf[5] = *(const v4u*)(HI + o_ + 8); pf[6] = *(const v4u*)(OH + o_); pf[7] = *(const v4u*)(OH + o_ + 8); pd = *(const f32x4*)(dend_c + (size_t)(n) * 128 + 4 * (tid & 31)); } while (0)
#define H2_STORE() do { *(LAS v4u*)(lds + H2_QE + ldq) = pf[0]; *(LAS v4u*)(lds + H2_QE + ldq + 16) = pf[1]; *(LAS v4u*)(lds + H2_KET + ldt) = pf[2]; *(LAS v4u*)(lds + H2_KET + ldt + 16) = pf[3]; \
        *(LAS v4u*)(lds + H2_VT + ldt) = pf[4]; *(LAS v4u*)(lds + H2_VT + ldt + 16) = pf[5]; *(LAS v4u*)(lds + H2_OIT + ldt) = pf[6]; *(LAS v4u*)(lds + H2_OIT + ldt + 16) = pf[7]; \
        if (tid < 32) *(LAS f32x4*)(lds + H2_DEND + 16 * tid) = pd; } while (0)
    bf16x8 Sb[8]; f32x16 sA[2];
    if (first) { unsigned z0; asm volatile("v_mov_b32 %0, 0" : "=v"(z0)); for (int u = tid; u < 32768 / 16; u += 512) *(LAS v4u*)(lds + H2_XS + u * 16) = (v4u){z0, z0, z0, z0};
#pragma unroll
        for (int t = 0; t < 2; ++t) sA[t] = (f32x16){}; }
    else {
#pragma unroll
        for (int t = 0; t < 2; ++t)
#pragma unroll
            for (int r = 0; r < 16; ++r) sA[t][r] = *(const LAS float*)(lds + ((wave * 2 + t) * 16 + r) * 256 + lane * 4);
        LDS_BARRIER(); }
    const int ntok = tid >> 3, ncg = tid & 7;
    if (tid < 32) *(LAS f32x4*)(lds + C2_ONW + 16 * tid) = *(const f32x4*)(onw + 4 * tid);
    H2_LOAD(nb); H2_STORE(); H2_LOAD((nb + 1 < ne ? nb + 1 : ne - 1)); __syncthreads();
#pragma unroll
    for (int k = 0; k < 8; ++k) Sb[k] = *(const LAS bf16x8*)(lds + H2_XS + ((k >> 2) * 4 + (wave & 3)) * 4096 + (k & 3) * 1024 + lane * 16);
    for (int n = nb; n < ne; ++n) {
        if (mh == 0) hg2_compute<0>(lds, sA, Sb, n0, r32, hi, wave, lane); else hg2_compute<1>(lds, sA, Sb, n0, r32, hi, wave, lane);
        LDS_BARRIER();
        { const LAS float* OL = (const LAS float*)(lds + H2_OL) + ntok * 132 + 16 * ncg; f32x4 x[4]; float ss = 0.f;
#pragma unroll
          for (int j = 0; j < 4; ++j) { x[j] = *(const LAS f32x4*)(OL + 4 * j); ss += (x[j][0] * x[j][0] + x[j][1] * x[j][1]) + (x[j][2] * x[j][2] + x[j][3] * x[j][3]); }
          ss = red8(ss);
          const float rs = rsqrtf(ss * (1.f / HD) + EPS);
          f32x4 onv[4];
#pragma unroll
          for (int j = 0; j < 4; ++j) onv[j] = *(const LAS f32x4*)(lds + C2_ONW + (16 * ncg + 4 * j) * 4);
          v4u w0, w1; w0.x = pk2(x[0][0] * rs * onv[0][0], x[0][1] * rs * onv[0][1]); w0.y = pk2(x[0][2] * rs * onv[0][2], x[0][3] * rs * onv[0][3]); w0.z = pk2(x[1][0] * rs * onv[1][0], x[1][1] * rs * onv[1][1]); w0.w = pk2(x[1][2] * rs * onv[1][2], x[1][3] * rs * onv[1][3]);
          w1.x = pk2(x[2][0] * rs * onv[2][0], x[2][1] * rs * onv[2][1]); w1.y = pk2(x[2][2] * rs * onv[2][2], x[2][3] * rs * onv[2][3]); w1.z = pk2(x[3][0] * rs * onv[3][0], x[3][1] * rs * onv[3][1]); w1.w = pk2(x[3][2] * rs * onv[3][2], x[3][3] * rs * onv[3][3]);
          bf16* op = OH + blk0 + ((size_t)n * 64 + ntok) * BW + 16 * ncg; if (!DRY) { *(v4u*)op = w0; *(v4u*)(op + 8) = w1; } else asm volatile("" :: "v"(w0), "v"(w1)); }
        H2_STORE(); H2_LOAD((n + 2 < ne ? n + 2 : ne - 1));
        if (mh == 0) {
#pragma unroll
            for (int j = 0; j < 4; ++j) Sb[4 + j] = *(const LAS bf16x8*)(lds + H2_XS + (wave ^ 4) * 4096 + j * 1024 + lane * 16); }
        else {
#pragma unroll
            for (int j = 0; j < 4; ++j) Sb[j] = *(const LAS bf16x8*)(lds + H2_XS + (wave ^ 4) * 4096 + j * 1024 + lane * 16); }
        LDS_BARRIER();
    }
#pragma unroll
    for (int t = 0; t < 2; ++t)
#pragma unroll
        for (int r = 0; r < 16; ++r) *(LAS float*)(lds + ((wave * 2 + t) * 16 + r) * 256 + lane * 4) = sA[t][r];
    LDS_BARRIER();
#undef H2_LOAD
#undef H2_STORE
}

constexpr int G2_NW = 0, G2_QD = 17408, G2_UT = 34816, G2_KDT = 53248, G2_AQ = 71680, G2_GLW = 80896, G2_OLT = 80912, G2_XS = 113680;
#define G2_SFRAG(ks) (*(const LAS bf16x8*)(lds + G2_XS + (((ks) >> 2) * 4 + nq) * 4096 + ((ks) & 3) * 1024 + lane * 16))
template <int MH>
__device__ __forceinline__ void gdn2_a(LAS unsigned char* lds, f32x16& oacc, bf16x8 (&Vb)[4], int nq, int r32, int hi, int wave, int lane) {
    const int n0 = 32 * nq;
    f32x16 acc;
#pragma unroll
    for (int g = 0; g < 4; ++g) { const v2u w = *(const LAS v2u*)(lds + G2_UT + (n0 + r32) * 144 + (32 * MH + 8 * g + 4 * hi) * 2);
        acc[4 * g] = bflo(w.x); acc[4 * g + 1] = bfhi(w.x); acc[4 * g + 2] = bflo(w.y); acc[4 * g + 3] = bfhi(w.y); }
    oacc = (f32x16){};
#pragma unroll
    for (int ks = 0; ks < 8; ++ks) { const bf16x8 Bs = G2_SFRAG(ks);
        const bf16x8 A = *(const LAS bf16x8*)(lds + G2_NW + (32 * MH + r32) * 272 + (16 * ks + 8 * hi) * 2); acc = __builtin_amdgcn_mfma_f32_32x32x16_bf16(A, Bs, acc, 0, 0, 0);
        const bf16x8 A2 = *(const LAS bf16x8*)(lds + G2_QD + (32 * MH + r32) * 272 + (16 * ks + 8 * hi) * 2); oacc = __builtin_amdgcn_mfma_f32_32x32x16_bf16(A2, Bs, oacc, 0, 0, 0);
        if ((ks & 1) == 1) SBAR(); }
#pragma unroll
    for (int s2 = 0; s2 < 2; ++s2) { v4u w; w.x = cvtpk(acc[8 * s2], acc[8 * s2 + 1]); w.y = cvtpk(acc[8 * s2 + 2], acc[8 * s2 + 3]); w.z = cvtpk(acc[8 * s2 + 4], acc[8 * s2 + 5]); w.w = cvtpk(acc[8 * s2 + 6], acc[8 * s2 + 7]);
        Vb[2 * MH + s2] = __builtin_bit_cast(bf16x8, w); *(LAS v4u*)(lds + G2_OLT + (wave ^ 4) * 4096 + s2 * 1024 + lane * 16) = w; }
}
template <int MH>
__device__ __forceinline__ void gdn2_bc(LAS unsigned char* lds, f32x16& oacc, f32x16 (&sA)[2], bf16x8 (&Vb)[4], int nq, int r32, int hi, int wave, int lane) {
#pragma unroll
    for (int s2 = 0; s2 < 2; ++s2) Vb[2 * (1 - MH) + s2] = *(const LAS bf16x8*)(lds + G2_OLT + wave * 4096 + s2 * 1024 + lane * 16);
#pragma unroll
    for (int ks = 0; ks < 4; ++ks) { const bf16x8 A = *(const LAS bf16x8*)(lds + G2_AQ + (32 * MH + r32) * 144 + (16 * ks + 8 * hi) * 2); oacc = __builtin_amdgcn_mfma_f32_32x32x16_bf16(A, Vb[ks], oacc, 0, 0, 0); }
    { LAS float* OT = (LAS float*)(lds + G2_OLT + wave * 4096);
#pragma unroll
      for (int r = 0; r < 16; ++r) OT[(8 * (r >> 2) + 4 * hi + (r & 3)) * 32 + r32] = oacc[r]; }
    const float gl = *(const LAS float*)(lds + G2_GLW);
#pragma unroll
    for (int t = 0; t < 2; ++t) { const int mt = 2 * MH + t; f32x16 acc;
#pragma unroll
        for (int r = 0; r < 16; ++r) acc[r] = sA[t][r] * gl;
#pragma unroll
        for (int ks = 0; ks < 4; ++ks) { const bf16x8 A = *(const LAS bf16x8*)(lds + G2_KDT + (32 * mt + r32) * 144 + (16 * ks + 8 * hi) * 2); acc = __builtin_amdgcn_mfma_f32_32x32x16_bf16(A, Vb[ks], acc, 0, 0, 0); }
        sA[t] = acc;
#pragma unroll
        for (int s2 = 0; s2 < 2; ++s2) { v4u w; w.x = cvtpk(acc[8 * s2], acc[8 * s2 + 1]); w.y = cvtpk(acc[8 * s2 + 2], acc[8 * s2 + 3]); w.z = cvtpk(acc[8 * s2 + 4], acc[8 * s2 + 5]); w.w = cvtpk(acc[8 * s2 + 6], acc[8 * s2 + 7]);
            *(LAS v4u*)(lds + G2_XS + wave * 4096 + (2 * t + s2) * 1024 + lane * 16) = w; } }
}
template <bool DRY = false, int MODE = 3>
__device__ __forceinline__ void gdn_chain2(const bf16* GQ, const bf16* GK, const bf16* GV, bf16* OW, const bf16* AQK, const float* GLp, const float* onw, int b, int h, LAS unsigned char* lds, int tid, int nb, int ne, bool first) {
    asm volatile("" : "+v"(tid));
    const int wave = __builtin_amdgcn_readfirstlane(tid >> 6), lane = tid & 63, r32 = lane & 31, hi = lane >> 5, mh = wave >> 2;
    const size_t blk0 = ((size_t)b * TP) * BW + h * HD;
    const float* gl_c = GLp + (size_t)(b * 4 + h) * NCH;
    v4u pfA[9], pfB[9]; float pgA, pgB;
#define G2_ADDR int t_ = tid; asm volatile("" : "+v"(t_)); const int srow = t_ >> 3, sch = (t_ & 7) * 2; const size_t soff = (size_t)srow * BW + sch * 8; \
        const int ldq = srow * 272 + sch * 16, ldt = (2 * srow + (sch >> 3)) * 144 + (sch & 7) * 16; const size_t aq0 = ((size_t)b * TP) * 256 + h * 64 + (size_t)srow * 256 + (t_ & 7) * 8; const int lda = srow * 144 + (t_ & 7) * 16; \
        (void)soff; (void)ldq; (void)ldt; (void)aq0; (void)lda;
#define G2_LOAD(pf, pg, n) do { G2_ADDR const size_t o_ = blk0 + (size_t)(n) * 64 * BW + soff; pf[0] = *(const v4u*)(OW + o_); pf[1] = *(const v4u*)(OW + o_ + 8); pf[2] = *(const v4u*)(GV + o_); pf[3] = *(const v4u*)(GV + o_ + 8); \
        pf[4] = *(const v4u*)(GQ + o_); pf[5] = *(const v4u*)(GQ + o_ + 8); pf[6] = *(const v4u*)(GK + o_); pf[7] = *(const v4u*)(GK + o_ + 8); pf[8] = *(const v4u*)(AQK + aq0 + (size_t)(n) * 64 * 256); \
        pg = __hip_atomic_load(gl_c + (n), __ATOMIC_RELAXED, __HIP_MEMORY_SCOPE_AGENT); } while (0)
#define G2_STORE1(pf) do { G2_ADDR *(LAS v4u*)(lds + G2_NW + ldq) = pf[0]; *(LAS v4u*)(lds + G2_NW + ldq + 16) = pf[1]; *(LAS v4u*)(lds + G2_UT + ldt) = pf[2]; *(LAS v4u*)(lds + G2_UT + ldt + 16) = pf[3]; } while (0)
#define G2_STORE2(pf, pg) do { G2_ADDR *(LAS v4u*)(lds + G2_QD + ldq) = pf[4]; *(LAS v4u*)(lds + G2_QD + ldq + 16) = pf[5]; *(LAS v4u*)(lds + G2_KDT + ldt) = pf[6]; *(LAS v4u*)(lds + G2_KDT + ldt + 16) = pf[7]; \
        *(LAS v4u*)(lds + G2_AQ + lda) = pf[8]; if (t_ == 0) *(LAS float*)(lds + G2_GLW) = pg; } while (0)
    bf16x8 Vb[4]; f32x16 oacc; const int nq = wave & 3; f32x16 sA[2];
    if (first) { unsigned z0; asm volatile("v_mov_b32 %0, 0" : "=v"(z0)); for (int u = tid; u < 32768 / 16; u += 512) *(LAS v4u*)(lds + G2_XS + u * 16) = (v4u){z0, z0, z0, z0};
#pragma unroll
        for (int t = 0; t < 2; ++t) sA[t] = (f32x16){}; }
    else {
#pragma unroll
        for (int t = 0; t < 2; ++t)
#pragma unroll
            for (int r = 0; r < 16; ++r) sA[t][r] = *(const LAS float*)(lds + ((wave * 2 + t) * 16 + r) * 256 + lane * 4);
        LDS_BARRIER(); }
    const int ntok = tid >> 3, ncg = tid & 7;
    if (tid < 32) *(LAS f32x4*)(lds + C2_ONW + 16 * tid) = *(const f32x4*)(onw + 4 * tid);
    G2_LOAD(pfA, pgA, nb); G2_STORE1(pfA); G2_STORE2(pfA, pgA); G2_LOAD(pfA, pgA, nb + 1); G2_LOAD(pfB, pgB, (nb + 2 < ne ? nb + 2 : ne - 1)); __syncthreads();
#define G2_ITER(n, pf, pg) do { \
        if (MODE & 1) { if (mh == 0) gdn2_a<0>(lds, oacc, Vb, nq, r32, hi, wave, lane); else gdn2_a<1>(lds, oacc, Vb, nq, r32, hi, wave, lane); } \
        LDS_BARRIER(); \
        if (MODE & 2) G2_STORE1(pf); \
        if (MODE & 1) { if (mh == 0) gdn2_bc<0>(lds, oacc, sA, Vb, nq, r32, hi, wave, lane); else gdn2_bc<1>(lds, oacc, sA, Vb, nq, r32, hi, wave, lane); } \
        LDS_BARRIER(); \
        if (MODE & 2) { const LAS float* OL = (const LAS float*)(lds + G2_OLT + ((ntok >> 5) * 4 + (ncg >> 1)) * 4096) + (ntok & 31) * 32 + (ncg & 1) * 16; f32x4 x[4]; float ss = 0.f; \
          _Pragma("unroll") for (int j = 0; j < 4; ++j) { x[j] = *(const LAS f32x4*)(OL + 4 * j); ss += (x[j][0] * x[j][0] + x[j][1] * x[j][1]) + (x[j][2] * x[j][2] + x[j][3] * x[j][3]); } \
          ss = red8(ss); \
          const float rs = rsqrtf(ss * (1.f / HD) + EPS); \
          f32x4 onv[4]; \
          _Pragma("unroll") for (int j = 0; j < 4; ++j) onv[j] = *(const LAS f32x4*)(lds + C2_ONW + (16 * ncg + 4 * j) * 4); \
          v4u w0, w1; w0.x = pk2(x[0][0] * rs * onv[0][0], x[0][1] * rs * onv[0][1]); w0.y = pk2(x[0][2] * rs * onv[0][2], x[0][3] * rs * onv[0][3]); w0.z = pk2(x[1][0] * rs * onv[1][0], x[1][1] * rs * onv[1][1]); w0.w = pk2(x[1][2] * rs * onv[1][2], x[1][3] * rs * onv[1][3]); \
          w1.x = pk2(x[2][0] * rs * onv[2][0], x[2][1] * rs * onv[2][1]); w1.y = pk2(x[2][2] * rs * onv[2][2], x[2][3] * rs * onv[2][3]); w1.z = pk2(x[3][0] * rs * onv[3][0], x[3][1] * rs * onv[3][1]); w1.w = pk2(x[3][2] * rs * onv[3][2], x[3][3] * rs * onv[3][3]); \
          bf16* op = OW + blk0 + ((size_t)(n) * 64 + ntok) * BW + 16 * ncg; if (!DRY) { *(v4u*)op = w0; *(v4u*)(op + 8) = w1; } else asm volatile("" :: "v"(w0), "v"(w1)); } \
        if (MODE & 2) { G2_STORE2(pf, pg); G2_LOAD(pf, pg, ((n) + 3 < ne ? (n) + 3 : ne - 1)); } \
        LDS_BARRIER(); } while (0)
    for (int n = nb; n < ne; n += 2) { G2_ITER(n, pfA, pgA); G2_ITER(n + 1, pfB, pgB); }
#pragma unroll
    for (int t = 0; t < 2; ++t)
#pragma unroll
        for (int r = 0; r < 16; ++r) *(LAS float*)(lds + ((wave * 2 + t) * 16 + r) * 256 + lane * 4) = sA[t][r];
    LDS_BARRIER();
#undef G2_ITER
#undef G2_LOAD
#undef G2_ADDR
#undef G2_STORE1
#undef G2_STORE2
}

__device__ __forceinline__ void sb_naive_item(const bf16* Q, const bf16* K, const bf16* V, bf16* O, const float* qn, const float* kn, int b, int h, int blk, int tid) {
    const int qi = tid >> 2, part = tid & 3; const int t = blk * 128 + qi; const size_t rb = (size_t)b * TP; const int cb = h * HD + part * 32;
    float qt[32], acc[32];
    { const v4u* qp = (const v4u*)(Q + (rb + t) * BW + cb); float ss = 0.f;
#pragma unroll
      for (int j = 0; j < 4; ++j) { const v4u w = qp[j]; qt[8 * j + 0] = bflo(w.x); qt[8 * j + 1] = bfhi(w.x); qt[8 * j + 2] = bflo(w.y); qt[8 * j + 3] = bfhi(w.y); qt[8 * j + 4] = bflo(w.z); qt[8 * j + 5] = bfhi(w.z); qt[8 * j + 6] = bflo(w.w); qt[8 * j + 7] = bfhi(w.w); }
#pragma unroll
      for (int j = 0; j < 32; ++j) ss += qt[j] * qt[j];
      ss = red4(ss);
      const float rq = rsqrtf(ss * (1.f / HD) + EPS) * QSCALE;
#pragma unroll
      for (int j = 0; j < 32; ++j) { qt[j] *= rq * qn[part * 32 + j] * kn[part * 32 + j]; acc[j] = 0.f; } }
    float run = 0.f;
    const int tmax = blk * 128 + (tid >> 6) * 16 + 15;
    for (int s = tmax - 1; s >= PADF; --s) {
        const v4u* kp = (const v4u*)(K + (rb + s) * BW + cb); float d = 0.f, kk = 0.f;
#pragma unroll
        for (int j = 0; j < 4; ++j) { const v4u w = kp[j]; const float k0 = bflo(w.x), k1 = bfhi(w.x), k2 = bflo(w.y), k3 = bfhi(w.y), k4 = bflo(w.z), k5 = bfhi(w.z), k6 = bflo(w.w), k7 = bfhi(w.w);
            d += qt[8 * j] * k0 + qt[8 * j + 1] * k1 + qt[8 * j + 2] * k2 + qt[8 * j + 3] * k3 + qt[8 * j + 4] * k4 + qt[8 * j + 5] * k5 + qt[8 * j + 6] * k6 + qt[8 * j + 7] * k7;
            kk += k0 * k0 + k1 * k1 + k2 * k2 + k3 * k3 + k4 * k4 + k5 * k5 + k6 * k6 + k7 * k7; }
        d = red4(d); kk = red4(kk);
        const float z = d * rsqrtf(kk * (1.f / HD) + EPS); const float sp = softplusf_(z);
        if (s < t) { const float a = __expf(z - sp - run); run += sp; const v4u* vp = (const v4u*)(V + (rb + s) * BW + cb);
#pragma unroll
            for (int j = 0; j < 4; ++j) { const v4u w = vp[j]; acc[8 * j] += a * bflo(w.x); acc[8 * j + 1] += a * bfhi(w.x); acc[8 * j + 2] += a * bflo(w.y); acc[8 * j + 3] += a * bfhi(w.y);
                acc[8 * j + 4] += a * bflo(w.z); acc[8 * j + 5] += a * bfhi(w.z); acc[8 * j + 6] += a * bflo(w.w); acc[8 * j + 7] += a * bfhi(w.w); } }
    }
    v4u* op = (v4u*)(O + (rb + t) * BW + cb);
#pragma unroll
    for (int j = 0; j < 4; ++j) { v4u w; w.x = pk2(acc[8 * j], acc[8 * j + 1]); w.y = pk2(acc[8 * j + 2], acc[8 * j + 3]); w.z = pk2(acc[8 * j + 4], acc[8 * j + 5]); w.w = pk2(acc[8 * j + 6], acc[8 * j + 7]); op[j] = w; }
}
__device__ __forceinline__ void gdn_naive_chain(const bf16* GQ, const bf16* GK, const bf16* GV, bf16* O, const float* convw, const float* BETA, const float* GG, const float* onw, int b, int h, LAS float* sh, int tid) {
    const int e = tid >> 2, part = tid & 3, lane = tid & 63, wave = tid >> 6;
    float S[32];
#pragma unroll
    for (int j = 0; j < 32; ++j) S[j] = 0.f;
    const float onwe = onw[e];
    for (int t = 0; t < TP; ++t) {
        const size_t m = (size_t)b * TP + t;
        if (tid < 384) { const int which = tid >> 7, c = tid & 127, col = h * HD + c; const bf16* src = which == 0 ? GQ : (which == 1 ? GK : GV);
            float a = 0.f;
#pragma unroll
            for (int i = 0; i < 4; ++i) { const int tt = t - 3 + i; if (tt >= 0) a += bf2f(src[((size_t)b * TP + tt) * BW + col]) * convw[i * 1536 + which * 512 + col]; }
            sh[tid] = a * sigmoidf_(a); }
        __syncthreads();
        if (wave < 2) { const float x0 = sh[wave * 128 + lane], x1 = sh[wave * 128 + 64 + lane]; const float s = wave_sum(x0 * x0 + x1 * x1); if (lane == 0) sh[384 + wave] = rsqrtf(s + EPS); }
        __syncthreads();
        const float rq = sh[384] * QSCALE, rk = sh[385]; const float beta = BETA[m * 4 + h], eg = __expf(GG[m * 4 + h]);
        float ks = 0.f;
#pragma unroll
        for (int j = 0; j < 32; ++j) ks += sh[128 + part * 32 + j] * S[j];
        ks *= rk; ks = red4(ks);
        const float vn = beta * (sh[256 + e] - eg * ks) * rk;
        float o = 0.f;
#pragma unroll
        for (int j = 0; j < 32; ++j) { S[j] = eg * S[j] + sh[128 + part * 32 + j] * vn; o += sh[part * 32 + j] * S[j]; }
        o *= rq; o = red4(o);
        if (part == 0) sh[392 + e] = o;
        __syncthreads();
        if (wave == 0) { const float x0 = sh[392 + lane], x1 = sh[392 + 64 + lane]; const float s = wave_sum(x0 * x0 + x1 * x1); if (lane == 0) sh[386] = rsqrtf(s * (1.f / HD) + EPS); }
        __syncthreads();
        if (part == 0) O[m * BW + h * HD + e] = (bf16)f2bf(o * sh[386] * onwe);
    }
}
__device__ __forceinline__ void hg_naive_chain(const bf16* HQ, const bf16* HF, const bf16* HI, bf16* O, const float* lb, const float* onw, int b, int h, LAS float* sh, int tid) {
    const int e = tid >> 2, part = tid & 3, lane = tid & 63, wave = tid >> 6;
    float S[32];
#pragma unroll
    for (int j = 0; j < 32; ++j) S[j] = 0.f;
    const float onwe = onw[e];
    for (int t = 0; t < TP; ++t) {
        const size_t m = (size_t)b * TP + t;
        if (tid < 128) { const float x = bf2f(HQ[m * BW + h * HD + tid]); sh[tid] = x * sigmoidf_(x); }
        else if (tid < 256) { const int c = tid - 128; const float fp = bf2f(HF[m * BW + h * HD + c]); const float l = lb[h * HD + c]; sh[128 + c] = l + (1.f - l) * sigmoidf_(fp); sh[256 + c] = (1.f - l) * sigmoidf_(-fp); }
        else if (tid < 384) { const int c = tid - 256; sh[384 + c] = (t >= PADF) ? bf2f(HI[m * BW + h * HD + c]) : 0.f; }
        __syncthreads();
        const float ve = sh[384 + e]; float o = 0.f;
#pragma unroll
        for (int j = 0; j < 32; ++j) { S[j] = sh[128 + part * 32 + j] * S[j] + sh[256 + part * 32 + j] * ve; o += sh[part * 32 + j] * S[j]; }
        o = red4(o);
        if (part == 0) sh[520 + e] = o;
        __syncthreads();
        if (wave == 0) { const float x0 = sh[520 + lane], x1 = sh[520 + 64 + lane]; const float s = wave_sum(x0 * x0 + x1 * x1); if (lane == 0) sh[512] = rsqrtf(s * (1.f / HD) + EPS); }
        __syncthreads();
        if (part == 0) O[m * BW + h * HD + e] = (bf16)f2bf(o * sh[512] * onwe);
        __syncthreads();
    }
}

constexpr int FRONT_MODE = 31;
constexpr int MREAL = NB * TREAL;
__device__ __forceinline__ f32x4 skinny_tile(const bf16* A, int lda, const bf16* Bt, int K, int tile, int lane) {
    const int fr = lane & 15, fq = lane >> 4; f32x4 acc = {0.f, 0.f, 0.f, 0.f};
    const bf16* ap = A + (size_t)fr * lda + 8 * fq; const bf16* bp = Bt + (size_t)(16 * tile + fr) * K + 8 * fq;
    for (int k0 = 0; k0 < K / 32; k0 += 8) {
        bf16x8 a8[8], b8[8];
#pragma unroll
        for (int j = 0; j < 8; ++j) { a8[j] = *(const bf16x8*)(ap + 32 * (k0 + j)); b8[j] = *(const bf16x8*)(bp + 32 * (k0 + j)); }
#pragma unroll
        for (int j = 0; j < 8; ++j) acc = __builtin_amdgcn_mfma_f32_16x16x32_bf16(a8[j], b8[j], acc, 0, 0, 0); }
    return acc;
}

template <int NKS>
__device__ __forceinline__ f32x4 skinny_part(const bf16* A, int lda, const bf16* Bt, int K, int tile, int lane, int ks0) {
    const int fr = lane & 15, fq = lane >> 4; f32x4 acc = {0.f, 0.f, 0.f, 0.f};
    const bf16* ap = A + (size_t)fr * lda + 8 * fq + 32 * ks0; const bf16* bp = Bt + (size_t)(16 * tile + fr) * K + 8 * fq + 32 * ks0;
    constexpr int BT = NKS < 8 ? NKS : 8;
#pragma unroll
    for (int k0 = 0; k0 < NKS; k0 += BT) { bf16x8 a8[BT], b8[BT];
#pragma unroll
        for (int j = 0; j < BT; ++j) { a8[j] = *(const bf16x8*)(ap + 32 * (k0 + j)); b8[j] = *(const bf16x8*)(bp + 32 * (k0 + j)); }
#pragma unroll
        for (int j = 0; j < BT; ++j) acc = __builtin_amdgcn_mfma_f32_16x16x32_bf16(a8[j], b8[j], acc, 0, 0, 0); }
    return acc;
}

#define PHASE_LOCALS \
    const int tid = (wave_s << 6) + fresh_lane(); \
    const int lane = tid & 63, wave = wave_s; \
    const __attribute__((address_space(4))) Args* ap = (const __attribute__((address_space(4))) Args*)__builtin_amdgcn_kernarg_segment_ptr(); asm volatile("" : "+s"(ap)); \
    GLOBAL_AS unsigned char* wsg_ = (GLOBAL_AS unsigned char*)ap->ws; asm volatile("" : "+s"(wsg_)); unsigned char* ws = (unsigned char*)wsg_; \
    const int gw = blockIdx.x * 8 + wave, NGW = G * 8; (void)lane; (void)gw; (void)NGW; \
    float* FRONT = (float*)(ws + WS_FRONT); float* BETA = (float*)(ws + WS_BETA); float* GGp = (float*)(ws + WS_GG); \
    float* LB = (float*)(ws + WS_LB); float* WBA = (float*)(ws + WS_WBA); \
    bf16* XN = (bf16*)(ws + WS_XN); bf16* ARR = (bf16*)(ws + WS_ARR); bf16* OARR = (bf16*)(ws + WS_O); \
    bf16* Wt_in = (bf16*)(ws + WS_W); bf16* Wt_B = (bf16*)((unsigned char*)Wt_in + W_IN_BYTES); bf16* Wt_O = (bf16*)((unsigned char*)Wt_in + W_IN_BYTES + W_B_BYTES); \
    float* hin_big = layer == 0 ? (float*)gp(ap->x) : gp(ap->out); \
    (void)FRONT; (void)BETA; (void)GGp; (void)LB; (void)WBA; (void)XN; (void)ARR; (void)OARR; (void)Wt_in; (void)Wt_B; (void)Wt_O; (void)hin_big;
constexpr size_t ASZ = (size_t)R * BW;

template <int NR>
__device__ __forceinline__ void p1_rows(float* FRONT, float* hin_big, bf16* XN, float* BETA, float* GGp, const float* nw, const float* wba, const float* alg, const float* dtb, int m0, int lane) {
    f32x4 v[NR][4]; float rs[NR];
#pragma unroll
    for (int r = 0; r < NR; ++r) { const float* hr = hrow(FRONT, hin_big, m0 + r);
#pragma unroll
        for (int j = 0; j < 4; ++j) v[r][j] = *(const f32x4*)(hr + 4 * lane + 256 * j); }
#pragma unroll
    for (int r = 0; r < NR; ++r) { float ss = 0.f;
#pragma unroll
        for (int j = 0; j < 4; ++j) ss += (v[r][j].x * v[r][j].x + v[r][j].y * v[r][j].y) + (v[r][j].z * v[r][j].z + v[r][j].w * v[r][j].w);
        rs[r] = ss; }
#pragma unroll
    for (int r = 0; r < NR; ++r) rs[r] = rsqrtf(wave_sum(rs[r]) * (1.f / DM) + EPS);
#pragma unroll
    for (int j = 0; j < 4; ++j) { const f32x4 nwv = *(const f32x4*)(nw + 4 * lane + 256 * j);
#pragma unroll
        for (int r = 0; r < NR; ++r) { v[r][j] = v[r][j] * rs[r] * nwv; v2u o; o.x = pk2(v[r][j].x, v[r][j].y); o.y = pk2(v[r][j].z, v[r][j].w); *(v2u*)(XN + (size_t)(m0 + r) * DM + 4 * lane + 256 * j) = o; } }
    float db[NR], da[NR];
#pragma unroll
    for (int r = 0; r < NR; ++r) { db[r] = 0.f; da[r] = 0.f; }
#pragma unroll
    for (int c = 0; c < 8; ++c) { f32x4 w[4];
#pragma unroll
        for (int j = 0; j < 4; ++j) w[j] = *(const f32x4*)(wba + c * DM + 4 * lane + 256 * j);
#pragma unroll
        for (int r = 0; r < NR; ++r) { float d = 0.f;
#pragma unroll
            for (int j = 0; j < 4; ++j) d += (v[r][j].x * w[j].x + v[r][j].y * w[j].y) + (v[r][j].z * w[j].z + v[r][j].w * w[j].w);
            d = wave_sum(d);
            if (c < 4) db[r] = lane == c ? d : db[r]; else da[r] = lane == c - 4 ? d : da[r]; } }
    if (lane < 4) { const float ae = -__expf(alg[lane]), bias = dtb[lane];
#pragma unroll
        for (int r = 0; r < NR; ++r) { const int t = (m0 + r) % TP;
            BETA[(size_t)(m0 + r) * 4 + lane] = t >= PADF ? sigmoidf_(db[r]) : 0.f;
            GGp[(size_t)(m0 + r) * 4 + lane] = ae * softplusf_(da[r] + bias); } }
}

__global__ void __launch_bounds__(512, 2) fwd_kernel(Args a_kernarg) {
    extern __shared__ __attribute__((aligned(16))) unsigned char lds_raw[];
    LAS unsigned char* lds = (LAS unsigned char*)lds_raw;
    const int G = gridDim.x;
    const int wave_s = __builtin_amdgcn_readfirstlane(threadIdx.x >> 6);
    for (int u = threadIdx.x; u < (LDS_BYTES - LDS_CTL) / 4; u += 512) ((LAS unsigned*)(lds + LDS_CTL))[u] = 0u;
    __syncthreads();
    (void)xcd_barrier_post((unsigned*)(gp(a_kernarg.ws) + WS_CTL) + CW_BAR, (volatile LAS unsigned*)(lds + MISC_OFF) + 8, (int)threadIdx.x);
#define GRID_BARRIER() do { const int tb_ = (wave_s << 6) + fresh_lane(); \
        const __attribute__((address_space(4))) Args* apb_ = (const __attribute__((address_space(4))) Args*)__builtin_amdgcn_kernarg_segment_ptr(); asm volatile("" : "+s"(apb_)); \
        XcdBarrier bar_; bar_.bar = (unsigned*)(gp(apb_->ws) + WS_CTL) + CW_BAR; bar_.x = xb_xcc_id(); bar_.st = (volatile LAS unsigned*)(lds + MISC_OFF) + 8; xcd_barrier(bar_, tb_); } while (0)

    {
        const int layer = 0; PHASE_LOCALS
        const int gt = blockIdx.x * 512 + tid, NGT = G * 512;
        for (int i = gt; i < NB * FRONTR * DM; i += NGT) { const int c = i % DM, t = (i / DM) % FRONTR; FRONT[i] = t >= PADF ? gp(ap->meta)[(t - PADF) * DM + c] : 0.f; }
        if (FRONT_MODE & 1) {
            unsigned z0; asm volatile("v_mov_b32 %0, 0" : "=v"(z0)); const v4u zz = {z0, z0, z0, z0};
            for (int i = gt; i < 11 * NB * PADF * (BW / 8); i += NGT) { const int cc = i % (BW / 8), rr = (i / (BW / 8)) % PADF, bb = (i / ((BW / 8) * PADF)) % NB, aa = i / ((BW / 8) * PADF * NB);
                *(v4u*)(ARR + (size_t)aa * ASZ + ((size_t)bb * TP + rr) * BW + cc * 8) = zz; }
            bf16* HALO = (bf16*)(ws + WS_HALO);
            for (int i = gt; i < 3 * NB * 3 * (BW / 8); i += NGT) { const int cc = i % (BW / 8), rr = (i / (BW / 8)) % 3, bb = (i / ((BW / 8) * 3)) % NB, aa = i / ((BW / 8) * 3 * NB);
                *(v4u*)(HALO + (((size_t)aa * (R / 64) + bb * NCH) * 3 + rr) * BW + cc * 8) = zz; }
        }
        for (int i = gt; i < BW; i += NGT) { float lg[NLAYER], mx = -1e30f;
#pragma unroll
            for (int l = 0; l < NLAYER; ++l) { lg[l] = gp(ap->lb_logits)[l * BW + i]; mx = fmaxf(mx, lg[l]); }
            float s = 0.f;
#pragma unroll
            for (int l = 0; l < NLAYER; ++l) { lg[l] = __expf(lg[l] - mx); s += lg[l]; }
            float c = 0.f; LB[i] = 0.f;
#pragma unroll
            for (int l = 1; l < NLAYER; ++l) { c += lg[l] / s; LB[l * BW + i] = c; } }
        for (int i = gt; i < NLAYER * 8 * DM; i += NGT) { const int k = i % DM, c = (i / DM) % 8, l = i / (8 * DM); WBA[i] = gp(ap->w_in)[((size_t)l * DM + k) * NIN + 4096 + c]; }
    }
    GRID_BARRIER();

#pragma unroll 1
    for (int layer = 0; layer < NLAYER; ++layer) {
        {
            PHASE_LOCALS
            {
        LAS float* scr = (LAS float*)(lds + wave * 16384);
            constexpr int I_IN = (DM / 64) * (NINP / 32), I_B = 3 * (BW / 64) * (DM / 32), I_O = (DM / 64) * (DM / 32), I_L = I_IN + I_B + I_O;
            for (int it = gw; it < I_L; it += NGW) {
                const int l = layer; int r = it; bf16* wl = (bf16*)(ws + WS_W);
                if (r < I_IN) { const int kb = r / (NINP / 32), nb = r % (NINP / 32);
                    p0_transpose_item(gp(ap->w_in) + (size_t)l * DM * NIN, NIN, in_src_col(nb * 32), wl, DM, nb * 32, scr, kb * 64, lane); continue; }
                r -= I_IN;
                if (r < I_B) { const int br = r / ((BW / 64) * (DM / 32)), rr = r % ((BW / 64) * (DM / 32)); const int kb = rr / (DM / 32), nb = rr % (DM / 32);
                    p0_transpose_item(gp(ap->w_branch) + ((size_t)l * 3 + br) * BW * DM, DM, nb * 32, (bf16*)((unsigned char*)wl + W_IN_BYTES) + (size_t)br * DM * BW, BW, nb * 32, scr, kb * 64, lane); continue; }
                r -= I_B;
                { const int kb = r / (DM / 32), nb = r % (DM / 32);
                  p0_transpose_item(gp(ap->w_out) + (size_t)l * DM * DM, DM, nb * 32, (bf16*)((unsigned char*)wl + W_IN_BYTES + W_B_BYTES), DM, nb * 32, scr, kb * 64, lane); }
            }
            }
            { const float* nw = gp(ap->norm_w) + layer * DM; const float* wba = WBA + layer * 8 * DM; const float* alg = gp(ap->a_log) + layer * NH; const float* dtb = gp(ap->dt_bias) + layer * NH;
              const int NG4 = (R / 4) / NGW * NGW;
              for (int g4 = gw; g4 < NG4; g4 += NGW) p1_rows<4>(FRONT, hin_big, XN, BETA, GGp, nw, wba, alg, dtb, 4 * g4, lane);
              for (int m = 4 * NG4 + gw; m < R; m += NGW) p1_rows<1>(FRONT, hin_big, XN, BETA, GGp, nw, wba, alg, dtb, m, lane); }
        }
        GRID_BARRIER();
        {
            PHASE_LOCALS
            if (FRONT_MODE & 1) {
                bf16* HALO = (bf16*)(ws + WS_HALO);
                unsigned char* MX = (unsigned char*)(ws + WS_MIX); float* ZF = (float*)(ws + WS_ZF);
                { const int slot = wave >> 1, sl = wave & 1; constexpr int NT = (NA + 1536 + 3072) / 16;
                  for (int t0 = blockIdx.x * 4; t0 < NT; t0 += G * 4) { const int tile = t0 + slot; f32x4 acc = {0.f, 0.f, 0.f, 0.f};
                      if (tile < NT) acc = skinny_part<16>(XN + (size_t)PADF * DM, DM, Wt_in, DM, tile, lane, 16 * sl);
                      *(LAS f32x4*)(lds + wave * 1024 + lane * 16) = acc; LDS_BARRIER();
                      if (sl == 0 && tile < NT) { acc += *(const LAS f32x4*)(lds + (wave + 1) * 1024 + lane * 16);
                          if (tile < NA / 16) { const int col = 16 * tile + (lane & 15), t = col >> 9, c = col & 511;
#pragma unroll
                              for (int r = 0; r < 4; ++r) { const int i = 4 * (lane >> 4) + r; const bf16 v = (bf16)f2bf(acc[r]);
#pragma unroll
                                  for (int bb = 0; bb < NB; ++bb) { ARR[(size_t)t * ASZ + ((size_t)bb * TP + PADF + i) * BW + c] = v;
                                      if (t >= 2 && t <= 4 && i >= 13) HALO[(((size_t)(t - 2) * (R / 64) + bb * NCH + 1) * 3 + (i - 13)) * BW + c] = v; } } }
                          else if (tile < (NA + 1536) / 16) { const int col = 16 * tile - NA + (lane & 15);
#pragma unroll
                              for (int r = 0; r < 4; ++r) { const int i = 4 * (lane >> 4) + r; const float z = acc[r]; ZF[i * 1536 + col] = z * sigmoidf_(z); } }
                          else { const int col = 16 * tile - (NA + 1536) + (lane & 15), t = col >> 10, c = col & 1023;
#pragma unroll
                              for (int r = 0; r < 4; ++r) { const int i = 4 * (lane >> 4) + r; unsigned qq = (unsigned)(255.f * sigmoidf_(acc[r]) + 0.5f); qq = qq < 1u ? 1u : qq; const unsigned char q = (unsigned char)qq;
#pragma unroll
                                  for (int bb = 0; bb < NB; ++bb) MX[(size_t)t * R * DM + ((size_t)bb * TP + PADF + i) * DM + c] = q; } } }
                      LDS_BARRIER(); } }
                { unsigned z0; asm volatile("v_mov_b32 %0, 0" : "=v"(z0)); const v4u zz = {z0, z0, z0, z0};
                  for (int i = blockIdx.x * 512 + tid; i < NB * PADF * (BW / 8); i += G * 512) { const int cc = i % (BW / 8), rr = (i / (BW / 8)) % PADF, bb = i / ((BW / 8) * PADF);
                      *(v4u*)(ARR + (size_t)6 * ASZ + ((size_t)bb * TP + rr) * BW + cc * 8) = zz; } }
            }
            pg8::Gemm g{XN, Wt_in, (FRONT_MODE & 1) ? MREAL : R, NA, DM}; pg8::StaticOrder S; S.init((FRONT_MODE & 1) ? MREAL : R, NA, G, (int)blockIdx.x, FRONT_MODE & 1);
            pg8::EpiSplit E{ARR, (float*)(ws + WS_SSQ), (bf16*)(ws + WS_HALO)};
            pg8::gemm_phase<pg8::EpiSplit, pg8::StaticOrder, true, true>(lds, g, S, E, tid);
        }
        GRID_BARRIER();
        constexpr int C1 = 28, C2 = 66, A1 = 0, A2 = 0, M1 = 0, M2 = 0;
#define GDN_LD_(rw, itx) do { const int i_ = (itx) < nit_ ? (itx) : 0; gdn_local_load(rw, ARR + 2 * ASZ, ARR + 3 * ASZ, ARR + 4 * ASZ, (const bf16*)(ws + WS_HALO), BETA, GGp, (i_ % 16) >> 2, nlo_ + i_ / 16, i_ & 3, tid_); } while (0)
#define GDN_IT_(rw, itx) gdn_local_item(rw, ARR + 2 * ASZ, ARR + 3 * ASZ, ARR + 4 * ASZ, ARR + 9 * ASZ, (bf16*)(ws + WS_AQK), (float*)(ws + WS_GL), gp(ap->conv_w) + (size_t)layer * 4 * 1536, ((itx) % 16) >> 2, nlo_ + (itx) / 16, (itx) & 3, lds, tid_)
#define HG_LD_(rw, itx) do { const int i_ = (itx) < nit_ ? (itx) : 0; hg_local_load(rw, ARR + 5 * ASZ, ARR + 6 * ASZ, ARR + 7 * ASZ, (i_ % 16) >> 2, nlo_ + i_ / 16, i_ & 3, tid_); } while (0)
#define HG_IT_(rw, itx) hg_local_item(rw, ARR + 5 * ASZ, ARR + 6 * ASZ, ARR + 7 * ASZ, ARR + 10 * ASZ, (float*)(ws + WS_DEND), LB + layer * BW, ((itx) % 16) >> 2, nlo_ + (itx) / 16, (itx) & 3, lds, tid_)
#define LOCAL_ITEMS(nlo, nhi, WG0, NWG) do { \
            { const int tid_ = (wave_s << 6) + fresh_lane(); const int nlo_ = (nlo), nit_ = 16 * ((nhi) - (nlo)); GdnRaw rwa_, rwb_; GDN_LD_(rwa_, (WG0)); \
              for (int it = (WG0); it < nit_; it += 2 * (NWG)) { GDN_LD_(rwb_, it + (NWG)); GDN_IT_(rwa_, it); GDN_LD_(rwa_, it + 2 * (NWG)); if (it + (NWG) < nit_) GDN_IT_(rwb_, it + (NWG)); } } \
            { const int tid_ = (wave_s << 6) + fresh_lane(); const int nlo_ = (nlo), nit_ = 16 * ((nhi) - (nlo)); HgRaw rwa_, rwb_; HG_LD_(rwa_, (WG0)); \
              for (int it = (WG0); it < nit_; it += 2 * (NWG)) { HG_LD_(rwb_, it + (NWG)); HG_IT_(rwa_, it); HG_LD_(rwa_, it + 2 * (NWG)); if (it + (NWG) < nit_) HG_IT_(rwb_, it + (NWG)); } } } while (0)
#define MIX_ROUNDS(r0, r1) do { pg8::Gemm g{XN, Wt_in + (size_t)(NA + 1536) * DM, (FRONT_MODE & 2) ? MREAL : R, 3072, DM}; pg8::RangeOrder S; S.init((FRONT_MODE & 2) ? MREAL : R, 3072, NW_, (int)blockIdx.x, (FRONT_MODE & 2) ? 1 : 0); S.i0 = (r0); S.i1 = (r1); \
            pg8::EpiMixU8 E{(unsigned char*)(ws + WS_MIX)}; pg8::gemm_phase<pg8::EpiMixU8, pg8::RangeOrder, true, true>(lds, g, S, E, (wave_s << 6) + fresh_lane()); } while (0)
#define ATT_RANGE(lo, hi) do { \
            if ((lo) < (hi)) { const int t_ = (wave_s << 6) + fresh_lane(); if (t_ < 32) *(LAS f32x4*)(lds + SBL_QKT + 16 * t_) = *(const f32x4*)(gp(ap->sb_qn) + layer * HD + 4 * t_) * *(const f32x4*)(gp(ap->sb_kn) + layer * HD + 4 * t_); __syncthreads(); } \
            for (int it = (lo) + (int)blockIdx.x; it < (hi); it += NW_) { const int ui = 31 - it / 16, bh = it % 16; \
                if (ui >= 0) sb_unit(ARR + 8 * ASZ, ARR, ARR + ASZ, (const float*)(ws + WS_RKT), bh >> 2, bh & 3, ui, lds, (wave_s << 6) + fresh_lane()); \
                else { sb_naive_item(ARR + 8 * ASZ, ARR, ARR + ASZ, ARR + 8 * ASZ, gp(ap->sb_qn) + layer * HD, gp(ap->sb_kn) + layer * HD, bh >> 2, bh & 3, 0, (wave_s << 6) + fresh_lane()); __syncthreads(); } } \
            __syncthreads(); } while (0)
#define CHAIN_SEG(nb_, ne_, first_) do { \
            if (cw < 16) gdn_chain2(ARR + 2 * ASZ, ARR + 3 * ASZ, ARR + 4 * ASZ, ARR + 9 * ASZ, (const bf16*)(ws + WS_AQK), (const float*)(ws + WS_GL), gp(ap->gdn_on) + layer * HD, cw >> 2, cw & 3, lds, (wave_s << 6) + fresh_lane(), nb_, ne_, first_); \
            else hg_chain2(ARR + 5 * ASZ, ARR + 6 * ASZ, ARR + 7 * ASZ, ARR + 10 * ASZ, (const float*)(ws + WS_DEND), gp(ap->hg_on) + layer * HD, (cw - 16) >> 2, (cw - 16) & 3, lds, (wave_s << 6) + fresh_lane(), nb_, ne_, first_); } while (0)
        {
            PHASE_LOCALS
            { const float* SSQ = (const float*)(ws + WS_SSQ); float* RKT = (float*)(ws + WS_RKT);
              for (int i = blockIdx.x * 512 + tid; i < R * 4; i += G * 512) { const int row = i >> 2, hh = i & 3, t = row % TP;
                  if ((FRONT_MODE & 1) && t < FRONTR) { float ss = 0.f; const bf16* kp = ARR + (size_t)row * BW + hh * HD;
#pragma unroll 4
                      for (int j = 0; j < HD / 8; ++j) { const v4u w = *(const v4u*)(kp + 8 * j); const float a0 = bflo(w.x), a1 = bfhi(w.x), a2 = bflo(w.y), a3 = bfhi(w.y), a4 = bflo(w.z), a5 = bfhi(w.z), a6 = bflo(w.w), a7 = bfhi(w.w);
                          ss += (a0 * a0 + a1 * a1) + (a2 * a2 + a3 * a3) + (a4 * a4 + a5 * a5) + (a6 * a6 + a7 * a7); }
                      RKT[i] = rsqrtf(ss * (1.f / HD) + EPS); }
                  else { const f32x4 q4 = *(const f32x4*)(SSQ + (size_t)i * 4); RKT[i] = rsqrtf(((q4[0] + q4[1]) + (q4[2] + q4[3])) * (1.f / HD) + EPS); } } }
            LOCAL_ITEMS(0, C1, (int)blockIdx.x, G);
        }
        GRID_BARRIER();
        {
            const int cw = (int)blockIdx.x - (G - 32); const int NW_ = G - 32;
            { PHASE_LOCALS
              if (cw >= 0) CHAIN_SEG(0, C1, true); else { LOCAL_ITEMS(C1, C2, (int)blockIdx.x, NW_); ATT_RANGE(0, A1); if (M1 > 0) MIX_ROUNDS(0, M1); } }
            GRID_BARRIER();
            { PHASE_LOCALS
              if (cw >= 0) CHAIN_SEG(C1, C2, false);
              else { LOCAL_ITEMS(C2, NCH, (int)blockIdx.x, NW_); ATT_RANGE(A1, A2); if (M2 > M1) MIX_ROUNDS(M1, M2); } }
            GRID_BARRIER();
            { PHASE_LOCALS
              if (cw >= 0) CHAIN_SEG(C2, NCH, false);
              else {
                  ATT_RANGE(A2, 16 * 33);
                  MIX_ROUNDS(M2, 1 << 20); } }
        }
#undef LOCAL_ITEMS
#undef MIX_ROUNDS
#undef CHAIN_SEG
#undef ATT_RANGE
        GRID_BARRIER();
        {
            PHASE_LOCALS
            if (FRONT_MODE & 4) {
                const float* ZF = (const float*)(ws + WS_ZF);
                for (int i = blockIdx.x * 512 + tid; i < NB * 16 * (1536 / 8); i += G * 512) { const int c8 = i % 192, row = (i / 192) % 16, bb = i / (192 * 16); const int col = 8 * c8, t = col >> 9, c = col & 511;
                    bf16* op = OARR + (size_t)t * ASZ + ((size_t)bb * TP + PADF + row) * BW + c; const v4u o = *(const v4u*)op; const f32x4 g0 = *(const f32x4*)(ZF + row * 1536 + col), g1 = *(const f32x4*)(ZF + row * 1536 + col + 4);
                    v4u w; w.x = pk2(bflo(o.x) * g0[0], bfhi(o.x) * g0[1]); w.y = pk2(bflo(o.y) * g0[2], bfhi(o.y) * g0[3]); w.z = pk2(bflo(o.z) * g1[0], bfhi(o.z) * g1[1]); w.w = pk2(bflo(o.w) * g1[2], bfhi(o.w) * g1[3]);
                    *(v4u*)op = w; } }
            pg8::Gemm g{XN, Wt_in + (size_t)NA * DM, (FRONT_MODE & 4) ? MREAL : R, 1536, DM}; pg8::StaticOrder S; S.init((FRONT_MODE & 4) ? MREAL : R, 1536, G, (int)blockIdx.x, (FRONT_MODE & 4) ? 1 : 0);
            pg8::EpiZ E{OARR};
            pg8::gemm_phase<pg8::EpiZ, pg8::StaticOrder, true, true>(lds, g, S, E, tid);
        }
        GRID_BARRIER();
        if (FRONT_MODE & 8) { PHASE_LOCALS
            const unsigned char* MX = (const unsigned char*)(ws + WS_MIX); bf16* YF = (bf16*)(ws + WS_YF);
            for (int tile = blockIdx.x; tile < DM / 16; tile += G) { f32x4 acc = {0.f, 0.f, 0.f, 0.f}; const int br = wave >> 1, sl = wave & 1;
                if (wave < 6) acc = skinny_part<8>(OARR + (size_t)br * ASZ + (size_t)PADF * BW, BW, Wt_B + (size_t)br * DM * BW, BW, tile, lane, 8 * sl);
                *(LAS f32x4*)(lds + wave * 1024 + lane * 16) = acc; LDS_BARRIER();
                if (wave == 0) { f32x4 y = {0.f, 0.f, 0.f, 0.f}; const int col = 16 * tile + (lane & 15);
#pragma unroll
                    for (int b3 = 0; b3 < 3; ++b3) { const f32x4 p = *(const LAS f32x4*)(lds + (2 * b3) * 1024 + lane * 16) + *(const LAS f32x4*)(lds + (2 * b3 + 1) * 1024 + lane * 16);
#pragma unroll
                        for (int r = 0; r < 4; ++r) { const int i = 4 * (lane >> 4) + r; y[r] += p[r] * ((float)MX[(size_t)b3 * R * DM + ((size_t)PADF + i) * DM + col] * (1.f / 255.f)); } }
#pragma unroll
                    for (int r = 0; r < 4; ++r) YF[(4 * (lane >> 4) + r) * DM + col] = (bf16)f2bf(y[r]); }
                LDS_BARRIER(); } }
        {
            PHASE_LOCALS
            pg8::StaticOrder S; S.init((FRONT_MODE & 8) ? MREAL : R, DM, G, (int)blockIdx.x, (FRONT_MODE & 8) ? 1 : 0);
            pg8::Gemm g{OARR, Wt_B, (FRONT_MODE & 8) ? MREAL : R, DM, BW, 3, (size_t)ASZ * 2, (size_t)DM * BW * 2};
            pg8::EpiYseg E{XN, (const unsigned char*)(ws + WS_MIX)};
            pg8::gemm_phase<pg8::EpiYseg, pg8::StaticOrder, true, true>(lds, g, S, E, tid);
        }
        GRID_BARRIER();
        {
            PHASE_LOCALS
            if (FRONT_MODE & 16) { const bf16* YF = (const bf16*)(ws + WS_YF);
                for (int tile = blockIdx.x; tile < DM / 16; tile += G) { f32x4 acc = skinny_part<4>(YF, DM, Wt_O, DM, tile, lane, 4 * wave);
                    *(LAS f32x4*)(lds + wave * 1024 + lane * 16) = acc; LDS_BARRIER();
                    if (wave == 0) { const int col = 16 * tile + (lane & 15);
#pragma unroll
                        for (int w2 = 1; w2 < 8; ++w2) acc += *(const LAS f32x4*)(lds + w2 * 1024 + lane * 16);
#pragma unroll
                        for (int r = 0; r < 4; ++r) { const int i = 4 * (lane >> 4) + r;
#pragma unroll
                            for (int bb = 0; bb < NB; ++bb) FRONT[((size_t)bb * FRONTR + PADF + i) * DM + col] += acc[r]; } }
                    LDS_BARRIER(); } }
            pg8::Gemm g{XN, Wt_O, (FRONT_MODE & 16) ? MREAL : R, DM, DM}; pg8::StaticOrder S; S.init((FRONT_MODE & 16) ? MREAL : R, DM, G, (int)blockIdx.x, (FRONT_MODE & 16) ? 1 : 0);
            pg8::EpiRes E{FRONT, hin_big, FRONT, gp(ap->out)};
            pg8::gemm_phase<pg8::EpiRes, pg8::StaticOrder, true, true>(lds, g, S, E, tid);
        }
        GRID_BARRIER();
    }
}

extern "C" void kernel_launch(void* const* d_in, const int* in_sizes, int n_in, void* d_out, int out_size, void* d_ws, size_t ws_size, hipStream_t stream) {
    static int grid = 0;
    if (grid == 0) {
        if (n_in != 14 || ws_size < WS_END) { fprintf(stderr, "kernel_launch: need 14 inputs and %zu bytes of workspace (got %d, %zu)\n", (size_t)WS_END, n_in, ws_size); grid = -1; return; }
        int dev = 0, cus = 0, per_cu = 0;
        hipGetDevice(&dev); hipDeviceGetAttribute(&cus, hipDeviceAttributeMultiprocessorCount, dev);
        if (hipFuncSetAttribute((const void*)fwd_kernel, hipFuncAttributeMaxDynamicSharedMemorySize, LDS_BYTES) != hipSuccess) { fprintf(stderr, "kernel_launch: hipFuncSetAttribute failed\n"); grid = -1; return; }
        hipOccupancyMaxActiveBlocksPerMultiprocessor(&per_cu, (const void*)fwd_kernel, 512, LDS_BYTES);
        (void)hipGetLastError();
        if (per_cu < 1) fprintf(stderr, "kernel_launch: occupancy query reports %d\n", per_cu);
        grid = cus;
    }
    if (grid < 0) return;
    hipMemsetAsync((char*)d_ws + WS_CTL, 0, CTL_ZERO_BYTES, stream);
    Args a{};
    a.x = (const float*)d_in[0]; a.meta = (const float*)d_in[1]; a.norm_w = (const float*)d_in[2]; a.w_in = (const float*)d_in[3]; a.sb_qn = (const float*)d_in[4]; a.sb_kn = (const float*)d_in[5];
    a.conv_w = (const float*)d_in[6]; a.a_log = (const float*)d_in[7]; a.dt_bias = (const float*)d_in[8]; a.gdn_on = (const float*)d_in[9]; a.lb_logits = (const float*)d_in[10]; a.hg_on = (const float*)d_in[11];
    a.w_branch = (const float*)d_in[12]; a.w_out = (const float*)d_in[13]; a.out = (float*)d_out; a.ws = (unsigned char*)d_ws;
    hipLaunchKernelGGL(fwd_kernel, dim3(grid), dim3(512), LDS_BYTES, stream, a);
}
```

```cpp
#include <hip/hip_runtime.h>
#include <cstdio>
#include <cstdint>
namespace pg8 {
#define PG8_LAS __attribute__((address_space(3)))
typedef unsigned short bf16_t;
typedef short bf16x8 __attribute__((ext_vector_type(8)));
typedef float f32x4 __attribute__((ext_vector_type(4)));
typedef unsigned u32x4 __attribute__((ext_vector_type(4)));
typedef unsigned u32x2 __attribute__((ext_vector_type(2)));
constexpr int BM = 256, BK = 64, HALF = 128, HTB = HALF * BK * 2  , STAGE_BYTES = 8 * HTB, NXCD = 8, WGM = 8;

__host__ __device__ __forceinline__ int lds_byte(int r, int c) { const int st = (r >> 4) * 2 + (c >> 5), rr = r & 15, cc = c & 31, ob = rr * 64 + cc * 2; return st * 1024 + (ob ^ (((ob >> 9) & 1) << 5)); }
__host__ __device__ __forceinline__ void stage_rc(int b, int& R, int& C) { const int st = b / 1024, sb = b % 1024, swz = sb ^ (((sb >> 9) & 1) << 5); R = (st >> 1) * 16 + swz / 64; C = (st & 1) * 32 + (swz % 64) / 2; }
__host__ __device__ __forceinline__ int perm32(int rho) { const int n = rho >> 4, i = rho & 15; return 8 * (i >> 2) + 4 * n + (i & 3); }

struct Unit { int pm, pn, rb; };
struct Gemm { const bf16_t* A; const bf16_t* Bt; int M, N, K; int nseg = 1; size_t segA = 0, segB = 0; };

struct StaticOrder {
    int nM, nN, nwg, G, c, remap;
    __host__ __device__ void init(int M, int N, int G_, int c_, int remap_ = 0) { nM = M / BM; nN = N / BM; nwg = nM * nN; G = G_; c = c_; remap = remap_; }
    __host__ __device__ bool next(int i, Unit& u) const {
        const long L = (long)i * G + c; if (L >= nwg) return false;
        int wgid = (int)L; { const int q = nwg / NXCD, r = nwg % NXCD, xcd = wgid % NXCD, off = wgid / NXCD; wgid = (xcd < r ? xcd * (q + 1) : r * (q + 1) + (xcd - r) * q) + off; }
        const int nig = WGM * nN, gid = wgid / nig, fm = gid * WGM, gsz = (nM - fm) < WGM ? (nM - fm) : WGM;
        u.pm = fm + ((wgid % nig) % gsz); u.pn = (wgid % nig) / gsz;
        u.rb = remap ? ((u.pm >> 5) * 8320 + 128 + 256 * (u.pm & 31)) : u.pm * BM;
        return true;
    }
    __device__ __forceinline__ void a_ready(const Unit&) const {}
    __device__ __forceinline__ void done(const Unit&) const {}
};
struct RangeOrder : StaticOrder { int i0, i1;
    __host__ __device__ bool next(int i, Unit& u) const { return (i0 + i < i1) && StaticOrder::next(i0 + i, u); } };
typedef float f32x2 __attribute__((ext_vector_type(2)));
typedef __bf16 pg8_bf16x2 __attribute__((ext_vector_type(2)));
__device__ __forceinline__ unsigned cvt_pk_bf16(float lo, float hi) { const f32x2 v = {lo, hi}; const pg8_bf16x2 b = __builtin_convertvector(v, pg8_bf16x2); return __builtin_bit_cast(unsigned, b); }
template <class Epi, class Sched, bool ALIGN_EPI = false, bool SP2 = false>
__device__ __forceinline__ void gemm_phase(PG8_LAS unsigned char* lds, const Gemm g, const Sched& S, const Epi& E, int tid_in) {
    int tid_l = tid_in; asm volatile("" : "+v"(tid_l));
    const int tid = tid_l, wid = __builtin_amdgcn_readfirstlane(tid >> 6), lane = tid & 63, wr = wid >> 2, wc = wid & 3, fr = lane & 15, fq = lane >> 4;
    const int K = g.K, nts = K / BK, nt = nts * g.nseg;
    unsigned voffA[2], voffB[2];
#pragma unroll
    for (int i = 0; i < 2; ++i) { int R, C; stage_rc(tid * 16 + i * 8192, R, C); const int Rb = Epi::PERM ? ((R & ~31) + perm32(R & 31)) : R;
        voffA[i] = (unsigned)(R * K + C) * 2u; voffB[i] = (unsigned)(Rb * K + C) * 2u; }
    const size_t kstep = (size_t)(BK * 2);
    const size_t hstep = (size_t)HALF * K * 2;
    const size_t tstep = 2 * hstep;
    const unsigned ldsw = (unsigned)wid * 1024u;
    const int aoff = lds_byte(wr * 64 + fr, fq * 8), boff = lds_byte(wc * 32 + fr, fq * 8);
#define PG8_SA(b, h) (((b) * 2 + (h)) * HTB)
#define PG8_SB(b, h) ((4 + (b) * 2 + (h)) * HTB)
#define PG8_STAGE(bufoff, gbase, voff) do { _Pragma("unroll") for (int _i = 0; _i < 2; ++_i) \
        __builtin_amdgcn_global_load_lds((const unsigned*)((const char*)(gbase) + (voff)[_i]), (PG8_LAS unsigned*)(lds + (bufoff) + ldsw + _i * 8192), 16, 0, 0); } while (0)
#define PG8_LDA(dst, b, h) do { _Pragma("unroll") for (int m = 0; m < 4; ++m) _Pragma("unroll") for (int k = 0; k < 2; ++k) dst[m][k] = *(const PG8_LAS bf16x8*)(lds + PG8_SA(b, h) + aoff + m * 2048 + k * 1024); } while (0)
#define PG8_LDB(dst, b, h) do { _Pragma("unroll") for (int n = 0; n < 2; ++n) _Pragma("unroll") for (int k = 0; k < 2; ++k) dst[n][k] = *(const PG8_LAS bf16x8*)(lds + PG8_SB(b, h) + boff + n * 2048 + k * 1024); } while (0)
#define PG8_MMA(ai, bj, At, Bt) do { __builtin_amdgcn_s_setprio(1); _Pragma("unroll") for (int m = 0; m < 4; ++m) _Pragma("unroll") for (int n = 0; n < 2; ++n) _Pragma("unroll") for (int k = 0; k < 2; ++k) \
        acc[ai][bj][m][n] = __builtin_amdgcn_mfma_f32_16x16x32_bf16(Bt[n][k], At[m][k], acc[ai][bj][m][n], 0, 0, 0); __builtin_amdgcn_s_setprio(0); } while (0)
#define PG8_WAIT_V(n) asm volatile("s_waitcnt vmcnt(" #n ")" ::: "memory")
#define PG8_WAIT_L(n) asm volatile("s_waitcnt lgkmcnt(" #n ")" ::: "memory")
#define PG8_BAR __builtin_amdgcn_s_barrier()
#define PG8_SCHED __builtin_amdgcn_sched_barrier(0)
    Unit cur, nxt; int ui = 0;
    if (!S.next(0, cur)) return;
    f32x4 acc[2][2][4][2];
#pragma unroll
    for (int a = 0; a < 2; ++a)
#pragma unroll
        for (int b = 0; b < 2; ++b)
#pragma unroll
            for (int m = 0; m < 4; ++m)
#pragma unroll
                for (int n = 0; n < 2; ++n) acc[a][b][m][n] = (f32x4){0.f, 0.f, 0.f, 0.f};
    bf16x8 At[4][2], B0[2][2], B1[2][2];
    const char* cA = (const char*)g.A + (size_t)cur.rb * K * 2; const char* cB = (const char*)g.Bt + (size_t)cur.pn * tstep;
    S.a_ready(cur);
    if constexpr (SP2) {
        PG8_STAGE(PG8_SB(0, 0), cB, voffB); PG8_STAGE(PG8_SB(0, 1), cB + hstep, voffB); PG8_STAGE(PG8_SA(0, 0), cA, voffA); PG8_STAGE(PG8_SA(0, 1), cA + hstep, voffA);
        if (wr == 1) PG8_BAR;
        PG8_WAIT_V(2); PG8_BAR;
        PG8_STAGE(PG8_SB(1, 0), cB + kstep, voffB); PG8_STAGE(PG8_SA(1, 0), cA + kstep, voffA); PG8_STAGE(PG8_SB(1, 1), cB + hstep + kstep, voffB);
        PG8_WAIT_V(6); PG8_BAR;
    } else {
        PG8_STAGE(PG8_SB(0, 0), cB, voffB); PG8_STAGE(PG8_SA(0, 0), cA, voffA); PG8_STAGE(PG8_SB(0, 1), cB + hstep, voffB); PG8_STAGE(PG8_SA(0, 1), cA + hstep, voffA);
        if (wr == 1) PG8_BAR;
        PG8_WAIT_V(4); PG8_BAR;
        PG8_STAGE(PG8_SB(1, 0), cB + kstep, voffB); PG8_STAGE(PG8_SA(1, 0), cA + kstep, voffA); PG8_STAGE(PG8_SB(1, 1), cB + hstep + kstep, voffB);
        PG8_WAIT_V(6); PG8_BAR;
    }
    for (;;) {
        const bool has_next = S.next(ui + 1, nxt);
        const char* nA = has_next ? (const char*)g.A + (size_t)nxt.rb * K * 2 : cA; const char* nB = has_next ? (const char*)g.Bt + (size_t)nxt.pn * tstep : cB;
        for (int t = 0; t < nt; t += 2) {
            const bool last = (t == nt - 2);
#define PG8_AT(base, seg, tt) ((base) + (size_t)((tt) / nts) * (seg) + (size_t)((tt) % nts) * kstep)
            const char* a1 = PG8_AT(cA, g.segA, t + 1);
            const char* a2 = last ? nA : PG8_AT(cA, g.segA, t + 2); const char* b2 = last ? nB : PG8_AT(cB, g.segB, t + 2);
            const char* a3 = last ? nA + kstep : PG8_AT(cA, g.segA, t + 3); const char* b3 = last ? nB + kstep : PG8_AT(cB, g.segB, t + 3);
#undef PG8_AT
            if constexpr (Epi::SEG) { if (t > 0 && t % nts == 0) E.seg_switch(acc, cur, t / nts, wr, wc, fr, fq); }
            if (last && has_next) S.a_ready(nxt);
            if constexpr (SP2) {
            PG8_LDB(B0, 0, 0); PG8_LDB(B1, 0, 1); PG8_SCHED; PG8_LDA(At, 0, 0); PG8_STAGE(PG8_SA(1, 1), a1 + hstep, voffA);
            PG8_WAIT_V(8); PG8_WAIT_L(0); PG8_BAR; PG8_MMA(0, 0, At, B0); PG8_MMA(0, 1, At, B1); PG8_BAR; PG8_SCHED;
            PG8_LDA(At, 0, 1); PG8_STAGE(PG8_SB(0, 0), b2, voffB); PG8_STAGE(PG8_SB(0, 1), b2 + hstep, voffB); PG8_STAGE(PG8_SA(0, 0), a2, voffA);
            PG8_WAIT_V(8); PG8_WAIT_L(0); PG8_BAR; PG8_MMA(1, 0, At, B0); PG8_MMA(1, 1, At, B1); PG8_BAR; PG8_SCHED;
            PG8_LDB(B0, 1, 0); PG8_LDB(B1, 1, 1); PG8_SCHED; PG8_LDA(At, 1, 0); PG8_STAGE(PG8_SA(0, 1), a2 + hstep, voffA);
            PG8_WAIT_V(8); PG8_WAIT_L(0); PG8_BAR; PG8_MMA(0, 0, At, B0); PG8_MMA(0, 1, At, B1); PG8_BAR; PG8_SCHED;
            PG8_LDA(At, 1, 1); PG8_STAGE(PG8_SB(1, 0), b3, voffB); PG8_STAGE(PG8_SB(1, 1), b3 + hstep, voffB); PG8_STAGE(PG8_SA(1, 0), a3, voffA);
            PG8_WAIT_V(8); PG8_WAIT_L(0); PG8_BAR; PG8_MMA(1, 0, At, B0); PG8_MMA(1, 1, At, B1); PG8_BAR; PG8_SCHED;
            } else {
            PG8_LDB(B0, 0, 0); PG8_SCHED; PG8_LDA(At, 0, 0); PG8_STAGE(PG8_SA(1, 1), a1 + hstep, voffA);
            PG8_WAIT_L(8); PG8_BAR; PG8_WAIT_L(0); PG8_MMA(0, 0, At, B0); PG8_BAR; PG8_SCHED;
            PG8_LDB(B1, 0, 1); PG8_STAGE(PG8_SB(0, 0), b2, voffB);
            PG8_BAR; PG8_WAIT_L(0); PG8_MMA(0, 1, At, B1); PG8_BAR;
            PG8_LDA(At, 0, 1); PG8_STAGE(PG8_SA(0, 0), a2, voffA);
            PG8_BAR; PG8_WAIT_L(0); PG8_MMA(1, 0, At, B0); PG8_BAR; PG8_SCHED;
            PG8_STAGE(PG8_SB(0, 1), b2 + hstep, voffB);
            PG8_WAIT_V(6); PG8_BAR; PG8_MMA(1, 1, At, B1); PG8_BAR;
            PG8_LDB(B0, 1, 0); PG8_SCHED; PG8_LDA(At, 1, 0); PG8_STAGE(PG8_SA(0, 1), a2 + hstep, voffA);
            PG8_WAIT_L(8); PG8_BAR; PG8_WAIT_L(0); PG8_MMA(0, 0, At, B0); PG8_BAR; PG8_SCHED;
            PG8_LDB(B1, 1, 1); PG8_STAGE(PG8_SB(1, 0), b3, voffB);
            PG8_BAR; PG8_WAIT_L(0); PG8_MMA(0, 1, At, B1); PG8_BAR;
            PG8_LDA(At, 1, 1); PG8_STAGE(PG8_SA(1, 0), a3, voffA);
            PG8_BAR; PG8_WAIT_L(0); PG8_MMA(1, 0, At, B0); PG8_BAR; PG8_SCHED;
            PG8_STAGE(PG8_SB(1, 1), b3 + hstep, voffB);
            PG8_WAIT_V(6); PG8_BAR; PG8_MMA(1, 1, At, B1); PG8_BAR;
            }
        }
        if constexpr (ALIGN_EPI) { if (wr == 0) PG8_BAR; }
        if constexpr (!Epi::AFTER_DRAIN) { E(acc, cur, wr, wc, fr, fq); S.done(cur); }
        if (!has_next) break;
#pragma unroll
        for (int a = 0; a < 2; ++a)
#pragma unroll
            for (int b = 0; b < 2; ++b)
#pragma unroll
                for (int m = 0; m < 4; ++m)
#pragma unroll
                    for (int n = 0; n < 2; ++n) acc[a][b][m][n] = (f32x4){0.f, 0.f, 0.f, 0.f};
        cur = nxt; cA = nA; cB = nB; ++ui;
        if constexpr (ALIGN_EPI) { if (wr == 1) PG8_BAR; }
    }
    PG8_WAIT_V(0);
    if constexpr (!ALIGN_EPI) { if (wr == 0) PG8_BAR; }
    PG8_BAR;
    if constexpr (Epi::AFTER_DRAIN) { E.fused(acc, cur, wr, wc, fr, fq, lds, wid, lane); S.done(cur); }
#undef PG8_SA
#undef PG8_SB
#undef PG8_STAGE
#undef PG8_LDA
#undef PG8_LDB
#undef PG8_MMA
#undef PG8_WAIT_V
#undef PG8_WAIT_L
#undef PG8_BAR
#undef PG8_SCHED
}
}

constexpr int NB = 4, TP = 8320, TREAL = 8192, FRONTR = 128, PADF = 112, DM = 1024, BW = 512, HD = 128, NH = 4, NLAYER = 4;
constexpr int R = NB * TP;
constexpr int NIN = 9224;
constexpr int NA = 4608, NZM = 4608, NINP = NA + NZM;
constexpr float EPS = 1e-6f;
constexpr float QSCALE = 0.08838834764831845f;

constexpr size_t MiB = 1u << 20;
constexpr size_t WS_CTL = 0, CTL_ZERO_BYTES = 1 * MiB;
constexpr size_t WS_FRONT = 1 * MiB;
constexpr size_t WS_BETA = 3 * MiB;
constexpr size_t WS_GG = WS_BETA + (size_t)R * 4 * 4;
constexpr size_t WS_LB = WS_GG + (size_t)R * 4 * 4;
constexpr size_t WS_WBA = WS_LB + 8192;
constexpr size_t WS_W = WS_WBA + 131072;
constexpr size_t W_IN_BYTES = (size_t)NINP * DM * 2, W_B_BYTES = (size_t)3 * DM * BW * 2, W_O_BYTES = (size_t)DM * DM * 2;
constexpr size_t W_LAYER_BYTES = W_IN_BYTES + W_B_BYTES + W_O_BYTES;
constexpr size_t WS_XN = WS_W + W_LAYER_BYTES;
constexpr size_t ARR_BYTES = (size_t)R * BW * 2;
constexpr size_t WS_ARR = WS_XN + (size_t)R * DM * 2;
constexpr size_t WS_O = WS_ARR + 8 * ARR_BYTES;
constexpr size_t WS_SSQ = WS_ARR + 11 * ARR_BYTES;
constexpr size_t WS_DEND = WS_SSQ + (size_t)R * 16 * 4;
constexpr int NCH = TP / 64;
constexpr size_t WS_GL = WS_DEND + (size_t)16 * NCH * 128 * 4;
constexpr size_t WS_HALO = WS_GL + 16384;
constexpr size_t WS_AQK = WS_HALO + (size_t)3 * (R / 64) * 3 * BW * 2 + 4096;
constexpr size_t WS_RKT = WS_AQK + (size_t)R * 256 * 2;
constexpr size_t WS_MIX = WS_RKT + (size_t)R * 4 * 4;
constexpr size_t WS_YF = WS_MIX + (size_t)3 * R * DM;
constexpr size_t WS_ZF = WS_YF + 32768;
constexpr size_t WS_END = WS_ZF + 16 * 1536 * 4;
static_assert(WS_W % 256 == 0 && WS_XN % 256 == 0 && WS_ARR % 256 == 0 && WS_SSQ % 256 == 0 && WS_MIX % 256 == 0, "ws alignment");
constexpr int CW_BAR = 4096;

constexpr int LDS_BYTES = 147456;
constexpr int RING_BYTES = 131072, LDS_CTL = 147200, MISC_OFF = LDS_CTL + 64;

#define GAS __attribute__((address_space(1)))
#define LAS __attribute__((address_space(3)))
typedef unsigned short bf16;
typedef unsigned v4u __attribute__((ext_vector_type(4)));
typedef unsigned v2u __attribute__((ext_vector_type(2)));
typedef float f32x4 __attribute__((ext_vector_type(4)));
#define LDS_WAIT() asm volatile("s_waitcnt lgkmcnt(0)" ::: "memory")
#define LDS_BARRIER() do { asm volatile("s_waitcnt lgkmcnt(0)" ::: "memory"); __builtin_amdgcn_s_barrier(); asm volatile("" ::: "memory"); } while (0)
#define VM_WAIT() asm volatile("s_waitcnt vmcnt(0)" ::: "memory")
typedef float f32x2_t __attribute__((ext_vector_type(2))); typedef __bf16 bf16x2_t __attribute__((ext_vector_type(2)));
__device__ __forceinline__ unsigned pk2(float lo, float hi) { const f32x2_t v = {lo, hi}; const bf16x2_t b = __builtin_convertvector(v, bf16x2_t); return __builtin_bit_cast(unsigned, b); }
__device__ __forceinline__ unsigned f2bf(float f) { return pk2(f, 0.f) & 0xffffu; }
__device__ __forceinline__ float bflo(unsigned w) { return __builtin_bit_cast(float, w << 16); }
__device__ __forceinline__ float bfhi(unsigned w) { return __builtin_bit_cast(float, w & 0xffff0000u); }
__device__ __forceinline__ float bf2f(bf16 x) { return __builtin_bit_cast(float, ((unsigned)x) << 16); }
__device__ __forceinline__ float sigmoidf_(float x) { return __builtin_amdgcn_rcpf(1.f + __builtin_amdgcn_exp2f(-1.4426950408889634f * x)); }
__device__ __forceinline__ float softplusf_(float x) { return fmaxf(x, 0.f) + __logf(1.f + __expf(-fabsf(x))); }
__device__ __forceinline__ int fresh_lane() { int l; asm volatile("v_mbcnt_lo_u32_b32 %0, -1, 0\n\tv_mbcnt_hi_u32_b32 %0, -1, %0" : "=v"(l)); return l; }
template <int MASK> __device__ __forceinline__ float shx(float v) {
    if constexpr (MASK == 32) { auto rr = __builtin_amdgcn_permlane32_swap(__float_as_uint(v), __float_as_uint(v), false, false);
        const unsigned lo = rr[0], hi = rr[1]; const bool up = (fresh_lane() & 32) != 0; return __uint_as_float(up ? lo : hi); }
    else return __uint_as_float((unsigned)__builtin_amdgcn_ds_swizzle((int)__float_as_uint(v), (MASK << 10) | 0x1f));
}
template <int CTRL> __device__ __forceinline__ float dpp_add(float v) { return v + __uint_as_float((unsigned)__builtin_amdgcn_update_dpp(0, (int)__float_as_uint(v), CTRL, 0xf, 0xf, true)); }
__device__ __forceinline__ float red4(float v) { v = dpp_add<0xB1>(v); return dpp_add<0x4E>(v); }
__device__ __forceinline__ float red8(float v) { return dpp_add<0x141>(red4(v)); }
__device__ __forceinline__ float rows_sum(float v) {
    auto r16 = __builtin_amdgcn_permlane16_swap(__float_as_uint(v), __float_as_uint(v), false, false); v = __uint_as_float(r16[0]) + __uint_as_float(r16[1]);
    auto rr = __builtin_amdgcn_permlane32_swap(__float_as_uint(v), __float_as_uint(v), false, false); return __uint_as_float(rr[0]) + __uint_as_float(rr[1]);
}
__device__ __forceinline__ float wave_sum(float v) { return rows_sum(dpp_add<0x140>(red8(v))); }

#define XB_TMO      128
#define XB_XCNT(j)  (256  + 64 * (j))
#define XB_XSUB(j)  (1280 + 64 * (j))
#define XB_XGEN(j)  (2304 + 64 * (j))
#define XB_TOP      3328
#define XB_TOPGEN   3392
#define XCD_BAR_WORDS 3456
#define XB_SPIN_CAP (1u << 18)

__device__ __forceinline__ unsigned xb_ld(unsigned* p)              { return __hip_atomic_load(p, __ATOMIC_RELAXED, __HIP_MEMORY_SCOPE_AGENT); }
__device__ __forceinline__ unsigned xb_add(unsigned* p, unsigned v) { return __hip_atomic_fetch_add(p, v, __ATOMIC_RELAXED, __HIP_MEMORY_SCOPE_AGENT); }
__device__ __forceinline__ unsigned xb_xcc_id() { return (unsigned)__builtin_amdgcn_s_getreg((3 << 11) | 20) & 0xFu; }
#define XB_SPIN(cond, bar) do { unsigned _sp = 0; while (cond) { __builtin_amdgcn_s_sleep(1); \
    if ((++_sp & 255u) == 0u) { if (xb_ld(&(bar)[XB_TMO])) break; if (_sp > XB_SPIN_CAP) { atomicAdd(&(bar)[XB_TMO], 1u); break; } } } } while (0)

struct XcdBarrier {
    unsigned* bar; unsigned x;
    volatile LAS unsigned* st;
};

__device__ __forceinline__ XcdBarrier xcd_barrier_post(unsigned* bar, volatile LAS unsigned* st, int tid) {
    XcdBarrier b; b.bar = bar; b.x = xb_xcc_id(); b.st = st;
    if (tid == 0) (void)xb_add(&bar[XB_XCNT(b.x)], 1u);
    return b;
}
__device__ __forceinline__ void xcd_barrier_complete(unsigned* bar, unsigned x, unsigned& nloc, unsigned& nx) {
    const unsigned G = gridDim.x * gridDim.y * gridDim.z;
    unsigned sum, cnt, mine, sp = 0u;
    for (;;) {
        sum = 0u; cnt = 0u; mine = 0u;
#pragma unroll
        for (unsigned j = 0; j < 16; ++j) { const unsigned c = xb_ld(&bar[XB_XCNT(j)]); sum += c; cnt += (c > 0u) ? 1u : 0u; mine = (j == x) ? c : mine; }
        if (sum == G) break;
        __builtin_amdgcn_s_sleep(1);
        if ((++sp & 255u) == 0u) { if (xb_ld(&bar[XB_TMO])) break; if (sp > XB_SPIN_CAP) { atomicAdd(&bar[XB_TMO], 1u); break; } }
    }
    nloc = mine > 0u ? mine : 1u; nx = cnt > 0u ? cnt : 1u;
}

__device__ __forceinline__ void xcd_barrier(const XcdBarrier& b, int tid) {
    asm volatile("s_waitcnt vmcnt(0)" ::: "memory");
    __syncthreads();
    if (tid == 0) {
        unsigned* bar = b.bar;
        __builtin_amdgcn_s_waitcnt(0);
        unsigned nloc = b.st[0], nx = b.st[1];
        if (nloc == 0u) { xcd_barrier_complete(bar, b.x, nloc, nx); b.st[0] = nloc; b.st[1] = nx; }
        const unsigned old = xb_add(&bar[XB_XSUB(b.x)], 1u);
        const unsigned gen = old / nloc;
        if (old + 1u == (gen + 1u) * nloc) {
            __builtin_amdgcn_fence(__ATOMIC_RELEASE, "agent");
            asm volatile("s_waitcnt vmcnt(0)" ::: "memory");
            const unsigned og = xb_add(&bar[XB_TOP], 1u);
            const unsigned tg = og / nx;
            if (og + 1u == (tg + 1u) * nx) xb_add(&bar[XB_TOPGEN], 1u);
            else XB_SPIN(xb_ld(&bar[XB_TOPGEN]) == tg, bar);
            __builtin_amdgcn_fence(__ATOMIC_ACQUIRE, "agent");
            xb_add(&bar[XB_XGEN(b.x)], 1u);
            asm volatile("s_waitcnt vmcnt(0)" ::: "memory");
        } else {
            XB_SPIN(xb_ld(&bar[XB_XGEN(b.x)]) == gen, bar);
            __builtin_amdgcn_fence(__ATOMIC_ACQUIRE, "agent");
            asm volatile("s_waitcnt vmcnt(0)" ::: "memory");
        }
    }
    __syncthreads();
}

#define GLOBAL_AS __attribute__((address_space(1)))
template <class T> __device__ __forceinline__ T* gp(T* p) { return (T*)(GLOBAL_AS T*)p; }
struct Args {
    const float* x; const float* meta; const float* norm_w; const float* w_in; const float* sb_qn; const float* sb_kn; const float* conv_w;
    const float* a_log; const float* dt_bias; const float* gdn_on; const float* lb_logits; const float* hg_on; const float* w_branch; const float* w_out;
    float* out; unsigned char* ws;
};

__device__ __forceinline__ float* hrow(float* front, float* big, int m) {
    const int b = m / TP, t = m - b * TP;
    return t < FRONTR ? front + (size_t)(b * FRONTR + t) * DM : big + ((size_t)b * TREAL + (t - FRONTR)) * DM;
}

namespace pg8 {
struct EpiSplit {
    static constexpr bool PERM = true, AFTER_DRAIN = false, SEG = false;
    bf16_t* O; float* SSQ; bf16_t* HALO;
    __device__ __forceinline__ void operator()(const f32x4 (&acc)[2][2][4][2], const Unit& u, int wr, int wc, int fr, int fq) const {
        const int row0 = u.rb + wr * 64 + fr; const int colt = u.pn * BM; const int t = colt >> 9;
        bf16_t* base = O + (size_t)t * ((size_t)R * BW); const int col0 = (colt & 511) + wc * 32 + 8 * fq;
#pragma unroll
        for (int ai = 0; ai < 2; ++ai)
#pragma unroll
            for (int m = 0; m < 4; ++m) { bf16_t* rowp = base + (size_t)(row0 + ai * HALF + m * 16) * BW + col0;
#pragma unroll
                for (int bj = 0; bj < 2; ++bj) { const f32x4 v0 = acc[ai][bj][m][0], v1 = acc[ai][bj][m][1];
                    u32x4 w; w.x = cvt_pk_bf16(v0[0], v0[1]); w.y = cvt_pk_bf16(v0[2], v0[3]); w.z = cvt_pk_bf16(v1[0], v1[1]); w.w = cvt_pk_bf16(v1[2], v1[3]);
                    *(u32x4*)(rowp + bj * HALF) = w; } }
        if (t >= 2 && t <= 4 && fr >= 13) {
#pragma unroll
            for (int ai = 0; ai < 2; ++ai) { const int row = row0 + ai * HALF + 48; bf16_t* hp = HALO + (((size_t)(t - 2) * (R / 64) + (row >> 6)) * 3 + (fr - 13)) * BW + (colt & 511) + wc * 32 + 8 * fq;
#pragma unroll
                for (int bj = 0; bj < 2; ++bj) { const f32x4 v0 = acc[ai][bj][3][0], v1 = acc[ai][bj][3][1];
                    u32x4 w; w.x = cvt_pk_bf16(v0[0], v0[1]); w.y = cvt_pk_bf16(v0[2], v0[3]); w.z = cvt_pk_bf16(v1[0], v1[1]); w.w = cvt_pk_bf16(v1[2], v1[3]);
                    *(u32x4*)(hp + bj * HALF) = w; } }
        }
        if (t == 0) {
#pragma unroll
            for (int ai = 0; ai < 2; ++ai)
#pragma unroll
                for (int m = 0; m < 4; ++m)
#pragma unroll
                    for (int bj = 0; bj < 2; ++bj) { const f32x4 v0 = acc[ai][bj][m][0], v1 = acc[ai][bj][m][1];
                        float ss = (v0[0] * v0[0] + v0[1] * v0[1]) + (v0[2] * v0[2] + v0[3] * v0[3]) + (v1[0] * v1[0] + v1[1] * v1[1]) + (v1[2] * v1[2] + v1[3] * v1[3]);
                        ss = rows_sum(ss);
                        if (fq == 0) SSQ[(size_t)(row0 + ai * HALF + m * 16) * 16 + ((u.pn & 1) * 2 + bj) * 4 + wc] = ss; }
        }
    }
};
struct EpiZ {
    static constexpr bool PERM = true, AFTER_DRAIN = false, SEG = false;
    bf16_t* Oarr;
    __device__ __forceinline__ void operator()(const f32x4 (&acc)[2][2][4][2], const Unit& u, int wr, int wc, int fr, int fq) const {
        const int row0 = u.rb + wr * 64 + fr;
        bf16_t* base = Oarr + (size_t)(u.pn >> 1) * ((size_t)R * BW); const int col0 = (u.pn & 1) * 256 + wc * 32 + 8 * fq;
        u32x4 ol[2][4][2];
#pragma unroll
        for (int ai = 0; ai < 2; ++ai)
#pragma unroll
            for (int m = 0; m < 4; ++m)
#pragma unroll
                for (int bj = 0; bj < 2; ++bj) ol[ai][m][bj] = *(const u32x4*)(base + (size_t)(row0 + ai * HALF + m * 16) * BW + col0 + bj * HALF);
#pragma unroll
        for (int ai = 0; ai < 2; ++ai)
#pragma unroll
            for (int m = 0; m < 4; ++m) { bf16_t* rowp = base + (size_t)(row0 + ai * HALF + m * 16) * BW + col0;
#pragma unroll
                for (int bj = 0; bj < 2; ++bj) { const f32x4 v0 = acc[ai][bj][m][0], v1 = acc[ai][bj][m][1];
                    const u32x4 o = ol[ai][m][bj]; float z[8] = {v0[0], v0[1], v0[2], v0[3], v1[0], v1[1], v1[2], v1[3]};
                    float ov[8] = {bflo(o.x), bfhi(o.x), bflo(o.y), bfhi(o.y), bflo(o.z), bfhi(o.z), bflo(o.w), bfhi(o.w)};
#pragma unroll
                    for (int j = 0; j < 8; ++j) ov[j] = ov[j] * z[j] * sigmoidf_(z[j]);
                    u32x4 w; w.x = cvt_pk_bf16(ov[0], ov[1]); w.y = cvt_pk_bf16(ov[2], ov[3]); w.z = cvt_pk_bf16(ov[4], ov[5]); w.w = cvt_pk_bf16(ov[6], ov[7]);
                    *(u32x4*)(rowp + bj * HALF) = w; } }
    }
};
struct EpiMixU8 {
    static constexpr bool PERM = true, AFTER_DRAIN = false, SEG = false;
    unsigned char* MIX;
    __device__ __forceinline__ void operator()(const f32x4 (&acc)[2][2][4][2], const Unit& u, int wr, int wc, int fr, int fq) const {
        const int row0 = u.rb + wr * 64 + fr; const int mc = u.pn * 256;
        unsigned char* base = MIX + (size_t)(mc >> 10) * ((size_t)R * DM); const int col0 = (mc & 1023) + wc * 32 + 8 * fq;
#pragma unroll
        for (int ai = 0; ai < 2; ++ai)
#pragma unroll
            for (int m = 0; m < 4; ++m) { unsigned char* rowp = base + (size_t)(row0 + ai * HALF + m * 16) * DM + col0;
#pragma unroll
                for (int bj = 0; bj < 2; ++bj) { const f32x4 v0 = acc[ai][bj][m][0], v1 = acc[ai][bj][m][1]; unsigned q[8];
#pragma unroll
                    for (int j = 0; j < 4; ++j) { q[j] = (unsigned)(255.f * sigmoidf_(v0[j]) + 0.5f); q[4 + j] = (unsigned)(255.f * sigmoidf_(v1[j]) + 0.5f); q[j] = q[j] < 1u ? 1u : q[j]; q[4 + j] = q[4 + j] < 1u ? 1u : q[4 + j]; }
                    u32x2 w; w.x = q[0] | (q[1] << 8) | (q[2] << 16) | (q[3] << 24); w.y = q[4] | (q[5] << 8) | (q[6] << 16) | (q[7] << 24);
                    *(u32x2*)(rowp + bj * HALF) = w; } }
    }
};
struct EpiY {
    static constexpr bool PERM = true, AFTER_DRAIN = false, SEG = false;
    bf16_t* Y; const unsigned char* MIXb; int first;
    __device__ __forceinline__ void operator()(const f32x4 (&acc)[2][2][4][2], const Unit& u, int wr, int wc, int fr, int fq) const {
        const int row0 = u.rb + wr * 64 + fr; const int col0 = u.pn * BM + wc * 32 + 8 * fq;
#pragma unroll
        for (int ai = 0; ai < 2; ++ai)
#pragma unroll
            for (int m = 0; m < 4; ++m) { const size_t off = (size_t)(row0 + ai * HALF + m * 16) * DM + col0;
#pragma unroll
                for (int bj = 0; bj < 2; ++bj) { const f32x4 v0 = acc[ai][bj][m][0], v1 = acc[ai][bj][m][1];
                    const u32x2 g = *(const u32x2*)(MIXb + off + bj * HALF); constexpr float I255 = 1.f / 255.f;
                    float r[8] = {v0[0] * (float)(g.x & 255u) * I255, v0[1] * (float)((g.x >> 8) & 255u) * I255, v0[2] * (float)((g.x >> 16) & 255u) * I255, v0[3] * (float)(g.x >> 24) * I255,
                                  v1[0] * (float)(g.y & 255u) * I255, v1[1] * (float)((g.y >> 8) & 255u) * I255, v1[2] * (float)((g.y >> 16) & 255u) * I255, v1[3] * (float)(g.y >> 24) * I255};
                    if (!first) { const u32x4 y = *(const u32x4*)(Y + off + bj * HALF);
                        r[0] += bflo(y.x); r[1] += bfhi(y.x); r[2] += bflo(y.y); r[3] += bfhi(y.y); r[4] += bflo(y.z); r[5] += bfhi(y.z); r[6] += bflo(y.w); r[7] += bfhi(y.w); }
                    u32x4 w; w.x = cvt_pk_bf16(r[0], r[1]); w.y = cvt_pk_bf16(r[2], r[3]); w.z = cvt_pk_bf16(r[4], r[5]); w.w = cvt_pk_bf16(r[6], r[7]);
                    *(u32x4*)(Y + off + bj * HALF) = w; } }
    }
};
struct EpiYseg {
    static constexpr bool PERM = true, AFTER_DRAIN = false, SEG = true;
    bf16_t* Y; const unsigned char* MIX;
    __device__ __forceinline__ void seg_switch(f32x4 (&acc)[2][2][4][2], const Unit& u, int s, int wr, int wc, int fr, int fq) const {
        const int row0 = u.rb + wr * 64 + fr; const int col0 = u.pn * BM + wc * 32 + 8 * fq;
        const unsigned char* ga = MIX + (size_t)(s - 1) * R * DM; const unsigned char* gb = MIX + (size_t)s * R * DM;
#pragma unroll
        for (int ai = 0; ai < 2; ++ai) { u32x2 av[4][2], bv[4][2];
#pragma unroll
            for (int m = 0; m < 4; ++m) { const size_t off = (size_t)(row0 + ai * HALF + m * 16) * DM + col0;
#pragma unroll
                for (int bj = 0; bj < 2; ++bj) { av[m][bj] = *(const u32x2*)(ga + off + bj * HALF); bv[m][bj] = *(const u32x2*)(gb + off + bj * HALF); } }
            __builtin_amdgcn_sched_barrier(0);
#pragma unroll
            for (int m = 0; m < 4; ++m) {
#pragma unroll
                for (int bj = 0; bj < 2; ++bj) { const u32x2 a = av[m][bj], b = bv[m][bj];
#pragma unroll
                    for (int j = 0; j < 4; ++j) { acc[ai][bj][m][0][j] *= (float)((a.x >> (8 * j)) & 255u) * __builtin_amdgcn_rcpf((float)((b.x >> (8 * j)) & 255u));
                                                  acc[ai][bj][m][1][j] *= (float)((a.y >> (8 * j)) & 255u) * __builtin_amdgcn_rcpf((float)((b.y >> (8 * j)) & 255u)); } } } }
    }
    __device__ __forceinline__ void operator()(const f32x4 (&acc)[2][2][4][2], const Unit& u, int wr, int wc, int fr, int fq) const {
        const int row0 = u.rb + wr * 64 + fr; const int col0 = u.pn * BM + wc * 32 + 8 * fq; const unsigned char* gc = MIX + (size_t)2 * R * DM; constexpr float I255 = 1.f / 255.f;
        u32x2 gl[2][4][2];
#pragma unroll
        for (int ai = 0; ai < 2; ++ai)
#pragma unroll
            for (int m = 0; m < 4; ++m)
#pragma unroll
                for (int bj = 0; bj < 2; ++bj) gl[ai][m][bj] = *(const u32x2*)(gc + (size_t)(row0 + ai * HALF + m * 16) * DM + col0 + bj * HALF);
#pragma unroll
        for (int ai = 0; ai < 2; ++ai)
#pragma unroll
            for (int m = 0; m < 4; ++m) { const size_t off = (size_t)(row0 + ai * HALF + m * 16) * DM + col0;
#pragma unroll
                for (int bj = 0; bj < 2; ++bj) { const f32x4 v0 = acc[ai][bj][m][0], v1 = acc[ai][bj][m][1]; const u32x2 g = gl[ai][m][bj];
                    u32x4 w; w.x = cvt_pk_bf16(v0[0] * (float)(g.x & 255u) * I255, v0[1] * (float)((g.x >> 8) & 255u) * I255); w.y = cvt_pk_bf16(v0[2] * (float)((g.x >> 16) & 255u) * I255, v0[3] * (float)(g.x >> 24) * I255);
                    w.z = cvt_pk_bf16(v1[0] * (float)(g.y & 255u) * I255, v1[1] * (float)((g.y >> 8) & 255u) * I255); w.w = cvt_pk_bf16(v1[2] * (float)((g.y >> 16) & 255u) * I255, v1[3] * (float)(g.y >> 24) * I255);
                    *(u32x4*)(Y + off + bj * HALF) = w; } }
    }
};
struct EpiRes {
    static constexpr bool PERM = false, AFTER_DRAIN = false, SEG = false;
    float* in_front; float* in_big; float* out_front; float* out_big;
    __device__ __forceinline__ void operator()(const f32x4 (&acc)[2][2][4][2], const Unit& u, int wr, int wc, int fr, int fq) const {
        const int row0 = u.rb + wr * 64 + fr, col0 = u.pn * BM + wc * 32 + 4 * fq;
#pragma unroll
        for (int ai = 0; ai < 2; ++ai) { f32x4 hv[4][2][2];
#pragma unroll
            for (int m = 0; m < 4; ++m) { const float* ip = hrow(in_front, in_big, row0 + ai * HALF + m * 16) + col0;
#pragma unroll
                for (int bj = 0; bj < 2; ++bj)
#pragma unroll
                    for (int n = 0; n < 2; ++n) hv[m][bj][n] = *(const f32x4*)(ip + bj * HALF + n * 16); }
#pragma unroll
            for (int m = 0; m < 4; ++m) { float* op = hrow(out_front, out_big, row0 + ai * HALF + m * 16) + col0;
#pragma unroll
                for (int bj = 0; bj < 2; ++bj)
#pragma unroll
                    for (int n = 0; n < 2; ++n) *(f32x4*)(op + bj * HALF + n * 16) = hv[m][bj][n] + acc[ai][bj][m][n]; } }
    }
};
}

__device__ __forceinline__ void p0_transpose_item(const float* W, int ldw, int srccol0, bf16* WT, int K, int dstrow0, LAS float* scr, int k0, int lane) {
#pragma unroll 8
    for (int i = 0; i < 32; ++i) { const int kk = 2 * i + (lane >> 5); scr[kk * 33 + (lane & 31)] = W[(size_t)(k0 + kk) * ldw + srccol0 + (lane & 31)]; }
    LDS_WAIT(); asm volatile("" ::: "memory");
    const int c = lane & 7;
#pragma unroll
    for (int j = 0; j < 4; ++j) { const int n = (lane >> 3) + 8 * j; const LAS float* s = scr + (8 * c) * 33 + n;
        v4u o; o.x = pk2(s[0 * 33], s[1 * 33]); o.y = pk2(s[2 * 33], s[3 * 33]); o.z = pk2(s[4 * 33], s[5 * 33]); o.w = pk2(s[6 * 33], s[7 * 33]);
        *(v4u*)(WT + (size_t)(dstrow0 + n) * K + k0 + 8 * c) = o; }
    LDS_WAIT(); asm volatile("" ::: "memory");
}
__device__ __forceinline__ int in_src_col(int d) {
    if (d < 1024) return 512 + d;
    if (d < 2560) return 2048 + (d - 1024);
    if (d < 4096) return 4104 + (d - 2560);
    if (d < 4608) return d - 4096;
    if (d < 5120) return 1536 + (d - 4608);
    if (d < 5632) return 3584 + (d - 5120);
    if (d < 6144) return 5640 + (d - 5632);
    return 6152 + (d - 6144);
}

typedef short bf16x8 __attribute__((ext_vector_type(8)));
typedef short s16x4 __attribute__((ext_vector_type(4)));
typedef float f32x16 __attribute__((ext_vector_type(16)));
constexpr float LOG2E = 1.4426950408889634f;
constexpr float SB_THR = 160.f;
#define KSWZ(row, colB) ((row) * 256 + ((colB) ^ (((row) & 7) << 4)))
#define SBAR() __builtin_amdgcn_sched_barrier(0)
__device__ __forceinline__ int crow(int r, int hi) { return (r & 3) + 8 * (r >> 2) + 4 * hi; }
__device__ __forceinline__ unsigned cvtpk(float lo, float hi) { return pk2(lo, hi); }
__device__ __forceinline__ int v_st(int k, int c) { const int kk = (k & ~0xC) | ((k & 4) << 1) | ((k & 8) >> 1); return ((kk >> 3) * 4 + (c >> 5)) * 512 + ((kk & 7) * 32 + (c & 31)) * 2; }
__device__ __forceinline__ int v_rd_base(int lane) { return ((lane & 3) << 3) | (((lane >> 2) & 3) << 6) | (((lane >> 4) & 1) << 5) | (((lane >> 5) & 1) << 8); }
constexpr int v_rd_off(int d0, int ks, int half) { return d0 * 512 + ks * 4096 + half * 2048; }
template <int OFF> __device__ __forceinline__ s16x4 tr_read(int vb) {
    s16x4 r; asm volatile("ds_read_b64_tr_b16 %0, %1 offset:%2" : "=&v"(r) : "v"(vb), "i"(OFF) : "memory"); return r;
}
template <int D0> __device__ __forceinline__ void pv_one(f32x16& od, int vb, bf16x8 pa0, bf16x8 pa1, bf16x8 pa2, bf16x8 pa3) {
    const s16x4 l0 = tr_read<v_rd_off(D0, 0, 0)>(vb), h0 = tr_read<v_rd_off(D0, 0, 1)>(vb), l1 = tr_read<v_rd_off(D0, 1, 0)>(vb), h1 = tr_read<v_rd_off(D0, 1, 1)>(vb);
    const s16x4 l2 = tr_read<v_rd_off(D0, 2, 0)>(vb), h2 = tr_read<v_rd_off(D0, 2, 1)>(vb), l3 = tr_read<v_rd_off(D0, 3, 0)>(vb), h3 = tr_read<v_rd_off(D0, 3, 1)>(vb);
    asm volatile("s_waitcnt lgkmcnt(0)" ::: "memory"); SBAR();
#define PK(L, H) (bf16x8){L[0], L[1], L[2], L[3], H[0], H[1], H[2], H[3]}
    od = __builtin_amdgcn_mfma_f32_32x32x16_bf16(pa0, PK(l0, h0), od, 0, 0, 0);
    od = __builtin_amdgcn_mfma_f32_32x32x16_bf16(pa1, PK(l1, h1), od, 0, 0, 0);
    od = __builtin_amdgcn_mfma_f32_32x32x16_bf16(pa2, PK(l2, h2), od, 0, 0, 0);
    od = __builtin_amdgcn_mfma_f32_32x32x16_bf16(pa3, PK(l3, h3), od, 0, 0, 0);
#undef PK
}
__device__ __forceinline__ float permsum(float x) { auto rr = __builtin_amdgcn_permlane32_swap(__float_as_uint(x), __float_as_uint(x), false, false); return __uint_as_float(rr[0]) + __uint_as_float(rr[1]); }
__device__ __forceinline__ float permother(float x, int hi) { auto rr = __builtin_amdgcn_permlane32_swap(__float_as_uint(x), __float_as_uint(x), false, false); return hi ? __uint_as_float(rr[0]) : __uint_as_float(rr[1]); }

constexpr int SBL_QKT = 133120;
constexpr int SBL_V = 0, SBL_K = 32768, SBL_RK = 65536, SBL_FLAG = 65536 + 512, SBL_Q = 65536 + 1024;
template <bool MASKED>
__device__ __forceinline__ void sb_tile(f32x16 (&o)[4], float& run, const LAS unsigned char* ql, LAS unsigned char* Kl, LAS float* rkt, int vb, int r32, int hi, int kbase, int trow) {
    f32x16 p0 = {}, p1 = {};
#pragma unroll
    for (int d0 = 0; d0 < 8; ++d0) { const int cb = (d0 * 16 + hi * 8) * 2;
        const bf16x8 b0 = *(const LAS bf16x8*)(Kl + KSWZ(r32, cb)); const bf16x8 b1 = *(const LAS bf16x8*)(Kl + KSWZ(32 + r32, cb)); const bf16x8 qf = *(const LAS bf16x8*)(ql + d0 * 1024);
        p0 = __builtin_amdgcn_mfma_f32_32x32x16_bf16(b0, qf, p0, 0, 0, 0); p1 = __builtin_amdgcn_mfma_f32_32x32x16_bf16(b1, qf, p1, 0, 0, 0);
        if ((d0 & 1) == 1) SBAR(); }
    float z[32], tot[8], pt[8];
#pragma unroll
    for (int g = 0; g < 8; ++g) { const f32x4 rk = *(const LAS f32x4*)(rkt + (g >> 2) * 32 + (g & 3) * 8 + 4 * hi); float zz[4], s[4];
#pragma unroll
        for (int i = 0; i < 4; ++i) { const int r = (g & 3) * 4 + i; zz[i] = (g < 4 ? p0[r] : p1[r]) * rk[i];
            const float e = __builtin_amdgcn_exp2f(-fabsf(zz[i])); s[i] = fmaxf(zz[i], 0.f) + __builtin_amdgcn_logf(1.f + e);
            if (MASKED) { const int key = kbase + (g >> 2) * 32 + (g & 3) * 8 + 4 * hi + i; if (!(key < trow && key >= PADF)) s[i] = 0.f; } }
        s[2] += s[3]; s[1] += s[2]; s[0] += s[1]; tot[g] = s[0];
#pragma unroll
        for (int i = 0; i < 4; ++i) z[4 * g + i] = zz[i] - s[i]; }
#pragma unroll
    for (int g = 0; g < 8; ++g) pt[g] = permother(tot[g], hi);
    float E = run;
#pragma unroll
    for (int g = 7; g >= 0; --g) { const float off = E + (hi ? 0.f : pt[g]);
#pragma unroll
        for (int i = 0; i < 4; ++i) { float a = __builtin_amdgcn_exp2f(z[4 * g + i] - off);
            if (MASKED) { const int key = kbase + (g >> 2) * 32 + (g & 3) * 8 + 4 * hi + i; if (!(key < trow && key >= PADF)) a = 0.f; }
            z[4 * g + i] = a; }
        E += tot[g] + pt[g]; }
    run = E;
    bf16x8 pa0, pa1, pa2, pa3;
#define PK4(BASE, OUT) do { const unsigned a0 = cvtpk(z[BASE + 0], z[BASE + 1]), a1 = cvtpk(z[BASE + 2], z[BASE + 3]); \
        const unsigned b0_ = cvtpk(z[BASE + 4], z[BASE + 5]), b1_ = cvtpk(z[BASE + 6], z[BASE + 7]); \
        auto r0 = __builtin_amdgcn_permlane32_swap(a0, b0_, false, false); auto r1 = __builtin_amdgcn_permlane32_swap(a1, b1_, false, false); \
        v4u w = {r0[0], r1[0], r0[1], r1[1]}; OUT = __builtin_bit_cast(bf16x8, w); } while (0)
    PK4(0, pa0); PK4(8, pa1); PK4(16, pa2); PK4(24, pa3);
#undef PK4
    pv_one<0>(o[0], vb, pa0, pa1, pa2, pa3); pv_one<1>(o[1], vb, pa0, pa1, pa2, pa3); pv_one<2>(o[2], vb, pa0, pa1, pa2, pa3); pv_one<3>(o[3], vb, pa0, pa1, pa2, pa3);
}

template <bool DRY = false>
__device__ __forceinline__ void sb_unit(bf16* QO, const bf16* Kg, const bf16* Vg, const float* SSQ, int b, int h, int ui, LAS unsigned char* lds, int tid) {
    asm volatile("" : "+v"(tid));
    const int wid = __builtin_amdgcn_readfirstlane(tid >> 6), lane = tid & 63, r32 = lane & 31, hi = lane >> 5;
    const int T0 = 128 + 256 * ui; const size_t rb = (size_t)b * TP;
    LAS unsigned char* ql = lds + SBL_Q + wid * 8192 + lane * 16;
    const int jtop = T0 / 64 + 3, jhi = T0 / 64 + (wid >> 1);
    const int sr = tid >> 4, sc = (tid & 15) * 8, vst0 = v_st(sr, sc), vst1 = v_st(32 + sr, sc);
    LAS unsigned char* Vl = lds + SBL_V; LAS unsigned char* Kl = lds + SBL_K; LAS float* RK = (LAS float*)(lds + SBL_RK); volatile LAS int* FL = (volatile LAS int*)(lds + SBL_FLAG);
    const int vb0 = (int)(unsigned)(uintptr_t)Vl + v_rd_base(lane);
    v4u vs0, vs1, ks0, ks1; float sq;
#define SLOAD(j) do { const size_t r0_ = rb + (size_t)(j) * 64 + sr; vs0 = *(const v4u*)(Vg + r0_ * BW + h * HD + sc); vs1 = *(const v4u*)(Vg + (r0_ + 32) * BW + h * HD + sc); \
        ks0 = *(const v4u*)(Kg + r0_ * BW + h * HD + sc); ks1 = *(const v4u*)(Kg + (r0_ + 32) * BW + h * HD + sc); \
        sq = SSQ[(rb + (size_t)(j) * 64 + (tid & 63)) * 4 + h]; } while (0)
#define SWRITE(bf) do { *(LAS v4u*)(Vl + (bf) * 16384 + vst0) = vs0; *(LAS v4u*)(Vl + (bf) * 16384 + vst1) = vs1; \
        *(LAS v4u*)(Kl + (bf) * 16384 + KSWZ(sr, sc * 2)) = ks0; *(LAS v4u*)(Kl + (bf) * 16384 + KSWZ(32 + sr, sc * 2)) = ks1; \
        if (tid < 64) RK[(bf) * 64 + tid] = sq; } while (0)
    { const bf16* qp = QO + (rb + T0 + wid * 32 + r32) * BW + h * HD + hi * 8; v4u qw[8]; float ss = 0.f;
#pragma unroll
      for (int d0 = 0; d0 < 8; ++d0) qw[d0] = *(const v4u*)(qp + d0 * 16);
#pragma unroll
      for (int d0 = 0; d0 < 8; ++d0) { const v4u w = qw[d0];
          const float f0 = bflo(w.x), f1 = bfhi(w.x), f2 = bflo(w.y), f3 = bfhi(w.y), f4 = bflo(w.z), f5 = bfhi(w.z), f6 = bflo(w.w), f7 = bfhi(w.w);
          ss += (f0 * f0 + f1 * f1) + (f2 * f2 + f3 * f3) + (f4 * f4 + f5 * f5) + (f6 * f6 + f7 * f7); }
      ss = permsum(ss);
      const float rq = rsqrtf(ss * (1.f / HD) + EPS) * (QSCALE * LOG2E);
#pragma unroll
      for (int d0 = 0; d0 < 8; ++d0) { const int c0 = d0 * 16 + hi * 8; const f32x4 qa = *(const LAS f32x4*)(lds + SBL_QKT + c0 * 4), qb = *(const LAS f32x4*)(lds + SBL_QKT + c0 * 4 + 16);
          const v4u w0 = qw[d0]; v4u w;
          w.x = cvtpk(bflo(w0.x) * rq * qa[0], bfhi(w0.x) * rq * qa[1]); w.y = cvtpk(bflo(w0.y) * rq * qa[2], bfhi(w0.y) * rq * qa[3]);
          w.z = cvtpk(bflo(w0.z) * rq * qb[0], bfhi(w0.z) * rq * qb[1]); w.w = cvtpk(bflo(w0.w) * rq * qb[2], bfhi(w0.w) * rq * qb[3]);
          *(LAS v4u*)(ql + d0 * 1024) = w; } }
    f32x16 o[4] = {}; float run = 0.f; bool done = false;
    SLOAD(jtop); SWRITE(0); __syncthreads();
    int it = 0;
    for (int j = jtop; j >= 1; --j, ++it) {
        const int cur = it & 1;
        if (j > 1) SLOAD(j - 1);
        if (j <= jhi && !done) {
            const int trow = T0 + wid * 32 + r32;
            if (j == jhi || j == 1) sb_tile<true>(o, run, ql, Kl + cur * 16384, RK + cur * 64, vb0 + cur * 16384, r32, hi, j * 64, trow);
            else sb_tile<false>(o, run, ql, Kl + cur * 16384, RK + cur * 64, vb0 + cur * 16384, r32, hi, j * 64, trow);
            done = __all(run > SB_THR);
        }
        if (j > 1) SWRITE(cur ^ 1);
        if (lane == 0) FL[cur * 8 + wid] = done ? 1 : 0;
        __syncthreads();
        int all = 1;
#pragma unroll
        for (int w = 0; w < 8; ++w) all &= FL[cur * 8 + w];
        if (all) break;
    }
#undef SLOAD
#undef SWRITE
    { int t2 = tid; asm volatile("" : "+v"(t2)); const int lane = t2 & 63, r32 = lane & 31, hi = lane >> 5;
      LAS bf16* ot = (LAS bf16*)(lds + SBL_Q + wid * 8192);
#pragma unroll
      for (int r = 0; r < 16; ++r) { const int orow = crow(r, hi);
#pragma unroll
          for (int d0 = 0; d0 < 4; ++d0) ot[orow * 128 + d0 * 32 + r32] = (bf16)f2bf(o[d0][r]); }
      asm volatile("s_waitcnt lgkmcnt(0)" ::: "memory");
      bf16* op = QO + (rb + T0 + wid * 32) * BW + h * HD;
#pragma unroll
      for (int i = 0; i < 8; ++i) { const int pz = i * 64 + lane; const v4u w = *(const LAS v4u*)(lds + SBL_Q + wid * 8192 + pz * 16);
          if (!DRY) *(v4u*)(op + (size_t)(pz >> 4) * BW + (pz & 15) * 8) = w; else asm volatile("" :: "v"(w)); } }
    __syncthreads();
}

__device__ __forceinline__ int perm16(int c) { return (c & ~12) | ((c & 4) << 1) | ((c & 8) >> 1); }
constexpr int HL_QK = 0, HL_QK_STRIDE = 272;
constexpr int HL_AL = 60928, HL_AL_STRIDE = 144;
constexpr int HL_VT = HL_AL + 9216, HL_VT_STRIDE = 144;
constexpr int HL_ST = HL_VT + 18432;
constexpr int HL_RAW = HL_ST + 2048;
struct HgRaw { v4u q0, q1, f0, f1, i0, i1; };
__device__ __forceinline__ void hg_local_load(HgRaw& rw, const bf16* HQ, const bf16* HF, const bf16* HI, int b, int n, int h, int tid) {
    asm volatile("" : "+v"(tid));
    const size_t blk = ((size_t)b * TP + 64 * n) * BW + h * HD; const int row = tid >> 3, ch = (tid & 7) * 2; const size_t go = blk + (size_t)row * BW + ch * 8;
    rw.q0 = *(const v4u*)(HQ + go); rw.q1 = *(const v4u*)(HQ + go + 8); rw.f0 = *(const v4u*)(HF + go); rw.f1 = *(const v4u*)(HF + go + 8); rw.i0 = *(const v4u*)(HI + go); rw.i1 = *(const v4u*)(HI + go + 8);
}
template <bool DRY = false>
__device__ __forceinline__ void hg_local_item(const HgRaw& rw, bf16* HQ, bf16* HF, bf16* HI, bf16* OH, float* DEND, const float* lb, int b, int n, int h, LAS unsigned char* lds, int tid) {
    asm volatile("" : "+v"(tid));
    const int c = tid & 127, seg = __builtin_amdgcn_readfirstlane(tid >> 7), lane = tid & 63, wave = __builtin_amdgcn_readfirstlane(tid >> 6);
    const size_t blk = ((size_t)b * TP + 64 * n) * BW + h * HD;
    float qs[16], kk[16], vv[16], L[16];
    { const int row = tid >> 3, ch = (tid & 7) * 2;
      LAS unsigned char* rp = lds + HL_RAW + row * 256 + ch * 16;
      *(LAS v4u*)rp = rw.q0; *(LAS v4u*)(rp + 16) = rw.q1; *(LAS v4u*)(rp + 16384) = rw.f0; *(LAS v4u*)(rp + 16384 + 16) = rw.f1; *(LAS v4u*)(rp + 32768) = rw.i0; *(LAS v4u*)(rp + 32768 + 16) = rw.i1; }
    LDS_BARRIER();
    { const float l = lb[h * HD + c]; float run = 0.f; const LAS bf16* RW = (const LAS bf16*)(lds + HL_RAW);
#pragma unroll
      for (int i = 0; i < 16; ++i) { const int row = 16 * seg + i;
          const float q = bf2f(RW[row * 128 + c]), fp = bf2f(RW[8192 + row * 128 + c]), iv = bf2f(RW[16384 + row * 128 + c]);
          const float sg = sigmoidf_(fp); qs[i] = q * sigmoidf_(q); const float f = l + (1.f - l) * sg; kk[i] = (1.f - l) * (1.f - sg);
          run += __builtin_amdgcn_logf(f); L[i] = run; vv[i] = (64 * n + row >= PADF) ? iv : 0.f; } }
    LAS float* ST = (LAS float*)(lds + HL_ST);
    ST[seg * 128 + c] = L[15];
    { unsigned z0; asm volatile("v_mov_b32 %0, 0" : "=v"(z0)); for (int u = tid; u < 9216 / 16; u += 512) *(LAS v4u*)(lds + HL_AL + u * 16) = (v4u){z0, z0, z0, z0}; }
    LDS_BARRIER();
    const float st0 = ST[c], st1 = ST[128 + c], st2 = ST[256 + c], st3 = ST[384 + c];
    const float ref = (seg > 0 ? st0 : 0.f) + (seg > 1 ? st1 : 0.f) + (seg > 2 ? st2 : 0.f);
    const float aft = (seg < 1 ? st1 : 0.f) + (seg < 2 ? st2 : 0.f) + (seg < 3 ? st3 : 0.f);
    const float own = seg == 0 ? st0 : (seg == 1 ? st1 : (seg == 2 ? st2 : st3));
    { const int pc = perm16(c); unsigned kw[8], vw[8];
#pragma unroll
      for (int i = 0; i < 16; ++i) ((LAS bf16*)(lds + HL_RAW))[(16 * seg + i) * 128 + pc] = (bf16)f2bf(qs[i] * __builtin_amdgcn_exp2f(ref + L[i]));
#pragma unroll
      for (int i = 0; i < 8; ++i) { kw[i] = pk2(kk[2 * i] * __builtin_amdgcn_exp2f(aft + own - L[2 * i]), kk[2 * i + 1] * __builtin_amdgcn_exp2f(aft + own - L[2 * i + 1])); vw[i] = pk2(vv[2 * i], vv[2 * i + 1]); }
      const size_t toff = blk + (size_t)(c >> 1) * BW + (c & 1) * 64 + 16 * seg;
      if (!DRY) { *(v4u*)(HF + toff) = (v4u){kw[0], kw[1], kw[2], kw[3]}; *(v4u*)(HF + toff + 8) = (v4u){kw[4], kw[5], kw[6], kw[7]};
      *(v4u*)(HI + toff) = (v4u){vw[0], vw[1], vw[2], vw[3]}; *(v4u*)(HI + toff + 8) = (v4u){vw[4], vw[5], vw[6], vw[7]}; }
      else asm volatile("" :: "v"(kw[0]), "v"(kw[1]), "v"(kw[2]), "v"(kw[3]), "v"(kw[4]), "v"(kw[5]), "v"(kw[6]), "v"(kw[7]));
      *(LAS v4u*)(lds + HL_VT + c * HL_VT_STRIDE + 32 * seg) = (v4u){vw[0], vw[1], vw[2], vw[3]}; *(LAS v4u*)(lds + HL_VT + c * HL_VT_STRIDE + 32 * seg + 16) = (v4u){vw[4], vw[5], vw[6], vw[7]};
      if (!DRY && seg == 0) DEND[((size_t)(b * 4 + h) * NCH + n) * 128 + c] = __builtin_amdgcn_exp2f(st0 + st1 + st2 + st3); }
    { LAS bf16* QK = (LAS bf16*)(lds + HL_QK);
#pragma unroll
      for (int i = 0; i < 16; ++i) QK[(16 * seg + i) * (HL_QK_STRIDE / 2) + c] = (bf16)f2bf(qs[i] * __builtin_amdgcn_exp2f(L[i]));
#pragma unroll
      for (int I = 0; I < 4; ++I) { if (I < seg) continue;
          const float D = (I == seg) ? -own : ((seg < 1 && I > 1 ? st1 : 0.f) + (seg < 2 && I > 2 ? st2 : 0.f));
          const int koff = 64 + 8 * I * (I + 1) + 16 * seg;
#pragma unroll
          for (int i = 0; i < 16; ++i) QK[(koff + i) * (HL_QK_STRIDE / 2) + c] = (bf16)f2bf(kk[i] * __builtin_amdgcn_exp2f(D + own - L[i])); } }
    LDS_BARRIER();
    { const int row = tid >> 3, ch = (tid & 7) * 2; const v4u q0 = *(const LAS v4u*)(lds + HL_RAW + row * 256 + ch * 16), q1 = *(const LAS v4u*)(lds + HL_RAW + row * 256 + ch * 16 + 16);
      if (!DRY) { *(v4u*)(HQ + blk + (size_t)row * BW + ch * 8) = q0; *(v4u*)(HQ + blk + (size_t)row * BW + ch * 8 + 8) = q1; } else asm volatile("" :: "v"(q0), "v"(q1)); }
    { const int fr = lane & 15, fq = lane >> 4;
      for (int bi = wave; bi < 10; bi += 8) { const int I = bi < 1 ? 0 : (bi < 3 ? 1 : (bi < 6 ? 2 : 3)); const int J = bi - (I * (I + 1)) / 2;
          f32x4 acc = {0.f, 0.f, 0.f, 0.f};
#pragma unroll
          for (int ks = 0; ks < 4; ++ks) { const bf16x8 A = *(const LAS bf16x8*)(lds + HL_QK + (16 * I + fr) * HL_QK_STRIDE + (32 * ks + 8 * fq) * 2);
              const bf16x8 B = *(const LAS bf16x8*)(lds + HL_QK + (64 + 8 * I * (I + 1) + 16 * J + fr) * HL_QK_STRIDE + (32 * ks + 8 * fq) * 2);
              acc = __builtin_amdgcn_mfma_f32_16x16x32_bf16(A, B, acc, 0, 0, 0); }
          LAS bf16* AL = (LAS bf16*)(lds + HL_AL);
#pragma unroll
          for (int r = 0; r < 4; ++r) { const int i = 4 * fq + r; const float x = (I == J && fr > i) ? 0.f : acc[r]; AL[(16 * I + i) * (HL_AL_STRIDE / 2) + 16 * J + fr] = (bf16)f2bf(x); } } }
    LDS_BARRIER();
    { const int fr = lane & 15, fq = lane >> 4; const int col = 16 * wave + fr;
#pragma unroll
      for (int mt = 0; mt < 4; ++mt) { f32x4 acc = {0.f, 0.f, 0.f, 0.f};
#pragma unroll
          for (int ks = 0; ks < 2; ++ks) { const bf16x8 A = *(const LAS bf16x8*)(lds + HL_AL + (16 * mt + fr) * HL_AL_STRIDE + (32 * ks + 8 * fq) * 2);
              const bf16x8 B = *(const LAS bf16x8*)(lds + HL_VT + col * HL_VT_STRIDE + (32 * ks + 8 * fq) * 2);
              acc = __builtin_amdgcn_mfma_f32_16x16x32_bf16(A, B, acc, 0, 0, 0); }
          v2u w; w.x = pk2(acc[0], acc[1]); w.y = pk2(acc[2], acc[3]);
          if (!DRY) *(v2u*)(OH + blk + (size_t)(col >> 1) * BW + (col & 1) * 64 + 16 * mt + 4 * fq) = w; else asm volatile("" :: "v"(w.x), "v"(w.y)); } }
    LDS_BARRIER();
}

constexpr int HC_QE = 0, HC_QE_STRIDE = 272;
constexpr int HC_KET = 17408, HC_T_STRIDE = 144;
constexpr int HC_VT = HC_KET + 18432, HC_OIT = HC_VT + 18432;
constexpr int HC_DEND = HC_OIT + 18432;
constexpr int HC_OL = HC_DEND + 512, HC_OL_STRIDE = 132;
template <bool DRY = false>
__device__ __forceinline__ void hg_chain(const bf16* HQ, const bf16* HF, const bf16* HI, bf16* OH, const float* DEND, const float* onw, int b, int h, LAS unsigned char* lds, int tid) {
    asm volatile("" : "+v"(tid));
    const int wave = __builtin_amdgcn_readfirstlane(tid >> 6), lane = tid & 63, r32 = lane & 31, hi = lane >> 5;
    const int srow = tid >> 3, sch = (tid & 7) * 2;
    const size_t blk0 = ((size_t)b * TP) * BW + h * HD; const size_t soff = (size_t)srow * BW + sch * 8;
    const int ldq = srow * HC_QE_STRIDE + sch * 16, ldt = (2 * srow + (sch >> 3)) * HC_T_STRIDE + (sch & 7) * 16;
    const float* dend_c = DEND + (size_t)(b * 4 + h) * NCH * 128;
    v4u pf[8]; f32x4 pd;
#define HC_LOAD(n) do { const size_t o_ = blk0 + (size_t)(n) * 64 * BW + soff; pf[0] = *(const v4u*)(HQ + o_); pf[1] = *(const v4u*)(HQ + o_ + 8); pf[2] = *(const v4u*)(HF + o_); pf[3] = *(const v4u*)(HF + o_ + 8); \
        pf[4] = *(const v4u*)(HI + o_); pf[5] = *(const v4u*)(HI + o_ + 8); pf[6] = *(const v4u*)(OH + o_); pf[7] = *(const v4u*)(OH + o_ + 8); pd = *(const f32x4*)(dend_c + (size_t)(n) * 128 + 4 * (tid & 31)); } while (0)
#define HC_STORE() do { *(LAS v4u*)(lds + HC_QE + ldq) = pf[0]; *(LAS v4u*)(lds + HC_QE + ldq + 16) = pf[1]; *(LAS v4u*)(lds + HC_KET + ldt) = pf[2]; *(LAS v4u*)(lds + HC_KET + ldt + 16) = pf[3]; \
        *(LAS v4u*)(lds + HC_VT + ldt) = pf[4]; *(LAS v4u*)(lds + HC_VT + ldt + 16) = pf[5]; *(LAS v4u*)(lds + HC_OIT + ldt) = pf[6]; *(LAS v4u*)(lds + HC_OIT + ldt + 16) = pf[7]; \
        if (tid < 32) *(LAS f32x4*)(lds + HC_DEND + 16 * tid) = pd; } while (0)
    f32x16 sA[4] = {}; bf16x8 Sb[8];
#pragma unroll
    for (int k = 0; k < 8; ++k) Sb[k] = (bf16x8){0, 0, 0, 0, 0, 0, 0, 0};
    const int n0 = 32 * wave;
    const int ntok = tid >> 3, ncg = tid & 7;
    HC_LOAD(0); HC_STORE(); __syncthreads();
    for (int n = 0; n < NCH; ++n) {
        if (n + 1 < NCH) HC_LOAD(n + 1);
        if (wave < 4) {
            LAS float* OL = (LAS float*)(lds + HC_OL);
#pragma unroll
            for (int mt = 0; mt < 2; ++mt) { f32x16 acc;
#pragma unroll
                for (int g = 0; g < 4; ++g) { const v2u w = *(const LAS v2u*)(lds + HC_OIT + (n0 + r32) * HC_T_STRIDE + (32 * mt + 8 * g + 4 * hi) * 2);
                    acc[4 * g] = bflo(w.x); acc[4 * g + 1] = bfhi(w.x); acc[4 * g + 2] = bflo(w.y); acc[4 * g + 3] = bfhi(w.y); }
#pragma unroll
                for (int ks = 0; ks < 8; ++ks) { const bf16x8 A = *(const LAS bf16x8*)(lds + HC_QE + (32 * mt + r32) * HC_QE_STRIDE + (16 * ks + 8 * hi) * 2);
                    acc = __builtin_amdgcn_mfma_f32_32x32x16_bf16(A, Sb[ks], acc, 0, 0, 0); }
#pragma unroll
                for (int r = 0; r < 16; ++r) OL[(32 * mt + 8 * (r >> 2) + 4 * hi + (r & 3)) * HC_OL_STRIDE + n0 + r32] = acc[r]; }
#pragma unroll
            for (int mt = 0; mt < 4; ++mt) { f32x16 acc;
#pragma unroll
                for (int g = 0; g < 4; ++g) { const f32x4 dv = *(const LAS f32x4*)(lds + HC_DEND + (32 * mt + 8 * g + 4 * hi) * 4);
#pragma unroll
                    for (int i = 0; i < 4; ++i) acc[4 * g + i] = sA[mt][4 * g + i] * dv[i]; }
#pragma unroll
                for (int ks = 0; ks < 4; ++ks) { const bf16x8 A = *(const LAS bf16x8*)(lds + HC_KET + (32 * mt + r32) * HC_T_STRIDE + (16 * ks + 8 * hi) * 2);
                    const bf16x8 B = *(const LAS bf16x8*)(lds + HC_VT + (n0 + r32) * HC_T_STRIDE + (16 * ks + 8 * hi) * 2);
                    acc = __builtin_amdgcn_mfma_f32_32x32x16_bf16(A, B, acc, 0, 0, 0); }
                sA[mt] = acc; }
#pragma unroll
            for (int kt = 0; kt < 4; ++kt)
#pragma unroll
                for (int s2 = 0; s2 < 2; ++s2) { v4u w; w.x = cvtpk(sA[kt][8 * s2], sA[kt][8 * s2 + 1]); w.y = cvtpk(sA[kt][8 * s2 + 2], sA[kt][8 * s2 + 3]);
                    w.z = cvtpk(sA[kt][8 * s2 + 4], sA[kt][8 * s2 + 5]); w.w = cvtpk(sA[kt][8 * s2 + 6], sA[kt][8 * s2 + 7]); Sb[2 * kt + s2] = __builtin_bit_cast(bf16x8, w); }
        }
        __syncthreads();
        { const LAS float* OL = (const LAS float*)(lds + HC_OL) + ntok * HC_OL_STRIDE + 16 * ncg; f32x4 x[4]; float ss = 0.f;
#pragma unroll
          for (int j = 0; j < 4; ++j) { x[j] = *(const LAS f32x4*)(OL + 4 * j); ss += (x[j][0] * x[j][0] + x[j][1] * x[j][1]) + (x[j][2] * x[j][2] + x[j][3] * x[j][3]); }
          ss = red8(ss);
          const float rs = rsqrtf(ss * (1.f / HD) + EPS);
          f32x4 onv[4];
#pragma unroll
          for (int j = 0; j < 4; ++j) onv[j] = *(const f32x4*)(onw + 16 * ncg + 4 * j);
          v4u w0, w1; w0.x = pk2(x[0][0] * rs * onv[0][0], x[0][1] * rs * onv[0][1]); w0.y = pk2(x[0][2] * rs * onv[0][2], x[0][3] * rs * onv[0][3]); w0.z = pk2(x[1][0] * rs * onv[1][0], x[1][1] * rs * onv[1][1]); w0.w = pk2(x[1][2] * rs * onv[1][2], x[1][3] * rs * onv[1][3]);
          w1.x = pk2(x[2][0] * rs * onv[2][0], x[2][1] * rs * onv[2][1]); w1.y = pk2(x[2][2] * rs * onv[2][2], x[2][3] * rs * onv[2][3]); w1.z = pk2(x[3][0] * rs * onv[3][0], x[3][1] * rs * onv[3][1]); w1.w = pk2(x[3][2] * rs * onv[3][2], x[3][3] * rs * onv[3][3]);
          bf16* op = OH + blk0 + ((size_t)n * 64 + ntok) * BW + 16 * ncg; if (!DRY) { *(v4u*)op = w0; *(v4u*)(op + 8) = w1; } else asm volatile("" :: "v"(w0), "v"(w1)); }
        if (n + 1 < NCH) HC_STORE();
        __syncthreads();
    }
#undef HC_LOAD
#undef HC_STORE
}

typedef short s16x4v __attribute__((ext_vector_type(4)));
constexpr int GL_QL = 0, GL_KL = 17408, GL_STR = 272;
constexpr int GL_VF = 34816, GL_VF_STR = 132;
constexpr int GL_KK = GL_VF + 64 * 132 * 4;
constexpr int GL_QK = GL_KK + 16384;
constexpr int GL_NM = GL_QK + 16384, GL_NM_STR = 144;
constexpr int GL_DL = GL_NM + 9216;
constexpr int GL_SC = GL_DL + 2048;
struct GdnRaw { v4u raw[3][5]; float bt, g; };
__device__ __forceinline__ void gdn_local_load(GdnRaw& rw, const bf16* GQ, const bf16* GK, const bf16* GV, const bf16* HALO, const float* BETA, const float* GG, int b, int n, int h, int tid) {
    asm volatile("" : "+v"(tid));
    const size_t blk = ((size_t)b * TP + 64 * n) * BW + h * HD; const int gch = b * NCH + n; const int cg = tid & 15, rp = tid >> 4;
    { const size_t m_ = (size_t)b * TP + 64 * n + (tid & 63); rw.bt = BETA[m_ * 4 + h]; rw.g = GG[m_ * 4 + h]; }
#pragma unroll
    for (int which = 0; which < 3; ++which) { const bf16* src = which == 0 ? GQ : (which == 1 ? GK : GV);
#pragma unroll
        for (int i = 0; i < 5; ++i) { const int row = 2 * rp - 3 + i;
            if (row >= 0) rw.raw[which][i] = *(const v4u*)(src + blk + (size_t)row * BW + 8 * cg);
            else if (n > 0) rw.raw[which][i] = *(const v4u*)(HALO + (((size_t)which * (R / 64) + gch - 1) * 3 + (3 + row)) * BW + h * HD + 8 * cg);
            else { unsigned z0; asm volatile("v_mov_b32 %0, 0" : "=v"(z0)); rw.raw[which][i] = (v4u){z0, z0, z0, z0}; } } }
}
template <bool DRY = false, int STEPS = 9>
__device__ __forceinline__ void gdn_local_item(const GdnRaw& rw, bf16* GQ, bf16* GK, bf16* GV, bf16* OW, bf16* AQK, float* GLp, const float* convw,
                                               int b, int n, int h, LAS unsigned char* lds, int tid) {
    asm volatile("" : "+v"(tid));
    const int c = tid & 127, seg = __builtin_amdgcn_readfirstlane(tid >> 7), lane = tid & 63, wave = __builtin_amdgcn_readfirstlane(tid >> 6), fr = lane & 15, fq = lane >> 4;
    const size_t blk = ((size_t)b * TP + 64 * n) * BW + h * HD;
    LAS float* SC = (LAS float*)(lds + GL_SC);
    const float bt_early = rw.bt, g_early = rw.g;
    { const int cg = tid & 15, rp = tid >> 4;
#pragma unroll
      for (int which = 0; which < 3; ++which) {
          f32x4 wv[4][2];
#pragma unroll
          for (int i = 0; i < 4; ++i) { wv[i][0] = *(const f32x4*)(convw + i * 1536 + which * 512 + h * HD + 8 * cg); wv[i][1] = *(const f32x4*)(convw + i * 1536 + which * 512 + h * HD + 8 * cg + 4); }
#pragma unroll
          for (int rr = 0; rr < 2; ++rr) { float y[8];
#pragma unroll
              for (int j = 0; j < 8; ++j) y[j] = 0.f;
#pragma unroll
              for (int i = 0; i < 4; ++i) { const v4u w = rw.raw[which][rr + i]; const float x[8] = {bflo(w.x), bfhi(w.x), bflo(w.y), bfhi(w.y), bflo(w.z), bfhi(w.z), bflo(w.w), bfhi(w.w)};
#pragma unroll
                  for (int j = 0; j < 8; ++j) y[j] += x[j] * wv[i][j >> 2][j & 3]; }
#pragma unroll
              for (int j = 0; j < 8; ++j) y[j] = y[j] * sigmoidf_(y[j]);
              const int row = 2 * rp + rr;
              if (which < 2) *(LAS v4u*)(lds + (which == 0 ? GL_QL : GL_KL) + row * GL_STR + 16 * cg) = (v4u){pk2(y[0], y[1]), pk2(y[2], y[3]), pk2(y[4], y[5]), pk2(y[6], y[7])};
              else { LAS float* vp = (LAS float*)(lds + GL_VF) + row * GL_VF_STR + 8 * cg; *(LAS f32x4*)vp = (f32x4){y[0], y[1], y[2], y[3]}; *(LAS f32x4*)(vp + 4) = (f32x4){y[4], y[5], y[6], y[7]}; } } } }
    LDS_BARRIER();
    if (STEPS <= 1) { LDS_BARRIER(); return; }
    for (int job = wave; job < 24; job += 8) { const int kind = job < 10 ? 0 : (job < 20 ? 1 : 2); const int bi = job < 10 ? job : (job < 20 ? job - 10 : 0);
        int I = bi < 1 ? 0 : (bi < 3 ? 1 : (bi < 6 ? 2 : 3)); int J = bi - (I * (I + 1)) / 2; if (kind == 2) { I = job - 20; J = I; }
        const int abase = kind == 0 ? GL_KL : GL_QL, bbase = kind == 2 ? GL_QL : GL_KL;
        f32x4 acc = {0.f, 0.f, 0.f, 0.f};
#pragma unroll
        for (int ks = 0; ks < 4; ++ks) { const bf16x8 A = *(const LAS bf16x8*)(lds + abase + (16 * I + fr) * GL_STR + (32 * ks + 8 * fq) * 2);
            const bf16x8 B = *(const LAS bf16x8*)(lds + bbase + (16 * J + fr) * GL_STR + (32 * ks + 8 * fq) * 2);
            acc = __builtin_amdgcn_mfma_f32_16x16x32_bf16(A, B, acc, 0, 0, 0); }
        if (kind < 2) { LAS float* D = (LAS float*)(lds + (kind == 0 ? GL_KK : GL_QK));
#pragma unroll
            for (int r = 0; r < 4; ++r) D[(16 * I + 4 * fq + r) * 64 + 16 * J + fr] = acc[r]; }
        if (kind != 1 && I == J) {
#pragma unroll
            for (int r = 0; r < 4; ++r) if (fr == 4 * fq + r) SC[(kind == 0 ? 0 : 64) + 16 * I + fr] = acc[r]; } }
    LDS_BARRIER();
    if (STEPS <= 2) { LDS_BARRIER(); return; }
    if (tid < 64) {
        SC[128 + tid] = rsqrtf(SC[tid] + EPS); SC[192 + tid] = rsqrtf(SC[64 + tid] + EPS) * QSCALE; SC[256 + tid] = bt_early;
        float gc = g_early;
#pragma unroll
        for (int d = 1; d < 64; d <<= 1) { const float o = __uint_as_float((unsigned)__builtin_amdgcn_ds_bpermute((tid - d) << 2, (int)__float_as_uint(gc))); gc += (tid >= d) ? o : 0.f; }
        SC[320 + tid] = gc * LOG2E; }
    LDS_BARRIER();
    if (STEPS <= 3) { LDS_BARRIER(); return; }
    { const int i = tid >> 3, jg = tid & 7; const float rki = SC[128 + i], rqi = SC[192 + i], bti = SC[256 + i], gci = SC[320 + i];
      float mv[8], av[8];
#pragma unroll
      for (int jj = 0; jj < 8; ++jj) { const int j = 8 * jg + jj; const float rkj = SC[128 + j], dec = __builtin_amdgcn_exp2f(fminf(gci - SC[320 + j], 0.f));
          const float kkv = ((const LAS float*)(lds + GL_KK))[i * 64 + j], qkv = ((const LAS float*)(lds + GL_QK))[i * 64 + j];
          mv[jj] = (j < i) ? -(bti * kkv * rki * rkj * dec) : 0.f; av[jj] = (j <= i) ? qkv * rqi * rkj * dec : 0.f; }
      *(LAS v4u*)(lds + GL_NM + i * GL_NM_STR + 16 * jg) = (v4u){pk2(mv[0], mv[1]), pk2(mv[2], mv[3]), pk2(mv[4], mv[5]), pk2(mv[6], mv[7])};
      bf16* ap = AQK + ((size_t)b * TP + 64 * n + i) * 256 + h * 64 + (jg >> 1) * 16 + (jg & 1) * 4;
      const v2u a0_ = (v2u){pk2(av[0], av[1]), pk2(av[2], av[3])}, a1_ = (v2u){pk2(av[4], av[5]), pk2(av[6], av[7])};
      if (!DRY) { *(v2u*)ap = a0_; *(v2u*)(ap + 8) = a1_; } else asm volatile("" :: "v"(a0_.x), "v"(a0_.y), "v"(a1_.x), "v"(a1_.y)); }
    LDS_BARRIER();
    if (STEPS <= 4) { LDS_BARRIER(); return; }
    if (wave == 0) { const int bb = lane >> 4, col = lane & 15; float x[16];
#pragma unroll
        for (int i = 0; i < 16; ++i) { float a = (i == col) ? 1.f : 0.f; const LAS bf16* mr = (const LAS bf16*)(lds + GL_NM + (16 * bb + i) * GL_NM_STR) + 16 * bb;
#pragma unroll
            for (int j = 0; j < 16; ++j) if (j < i) a += bf2f(mr[j]) * x[j];
            x[i] = a; }
#pragma unroll
        for (int i = 0; i < 16; ++i) ((LAS bf16*)(lds + GL_DL))[(bb * 16 + i) * 16 + col] = (bf16)f2bf(x[i]); }
    LDS_BARRIER();
    if (STEPS <= 5) { LDS_BARRIER(); return; }
#pragma unroll
    for (int tt = 0; tt < 2; ++tt) { const int ct = 2 * wave + tt; const bool isU = ct < 8; const int col = 16 * (ct & 7) + fr;
        s16x4v Xb[4];
#pragma unroll
        for (int bb = 0; bb < 4; ++bb) { f32x4 acc;
#pragma unroll
            for (int r = 0; r < 4; ++r) { const int row = 16 * bb + 4 * fq + r; const float bt = SC[256 + row];
                acc[r] = isU ? bt * ((const LAS float*)(lds + GL_VF))[row * GL_VF_STR + col]
                             : bt * __builtin_amdgcn_exp2f(SC[320 + row]) * SC[128 + row] * bf2f(((const LAS bf16*)(lds + GL_KL))[row * (GL_STR / 2) + col]); }
#pragma unroll
            for (int cc = 0; cc < 4; ++cc) if (cc < bb) { const s16x4v A = *(const LAS s16x4v*)(lds + GL_NM + (16 * bb + fr) * GL_NM_STR + (16 * cc + 4 * fq) * 2);
                acc = __builtin_amdgcn_mfma_f32_16x16x16bf16_1k(A, Xb[cc], acc, 0, 0, 0); }
            const s16x4v Dg = *(const LAS s16x4v*)(lds + GL_DL + ((bb * 16 + fr) * 16 + 4 * fq) * 2);
            v2u aw; aw.x = pk2(acc[0], acc[1]); aw.y = pk2(acc[2], acc[3]);
            f32x4 X = {0.f, 0.f, 0.f, 0.f}; X = __builtin_amdgcn_mfma_f32_16x16x16bf16_1k(Dg, __builtin_bit_cast(s16x4v, aw), X, 0, 0, 0);
            v2u xw; xw.x = pk2(X[0], X[1]); xw.y = pk2(X[2], X[3]); Xb[bb] = __builtin_bit_cast(s16x4v, xw);
            if (DRY) asm volatile("" :: "v"(xw.x), "v"(xw.y));
            else if (isU) *(v2u*)(GV + blk + (size_t)(col >> 1) * BW + (col & 1) * 64 + 16 * bb + 4 * fq) = xw;
            else { const int pc = perm16(col);
#pragma unroll
                for (int r = 0; r < 4; ++r) ((LAS bf16*)(lds + GL_KK))[(16 * bb + 4 * fq + r) * 128 + pc] = (bf16)f2bf(-X[r]); } } }
    if (STEPS <= 6) { LDS_BARRIER(); return; }
    { const int pc = perm16(c); const float gl = SC[320 + 63]; unsigned kw[8]; float kd[16];
#pragma unroll
      for (int i = 0; i < 16; ++i) { const int row = 16 * seg + i; const float gc = SC[320 + row];
          const float qv = bf2f(((const LAS bf16*)(lds + GL_QL))[row * (GL_STR / 2) + c]), kv = bf2f(((const LAS bf16*)(lds + GL_KL))[row * (GL_STR / 2) + c]);
          ((LAS bf16*)(lds + GL_QK))[row * 128 + pc] = (bf16)f2bf(qv * SC[192 + row] * __builtin_amdgcn_exp2f(gc));
          kd[i] = kv * SC[128 + row] * __builtin_amdgcn_exp2f(gl - gc); }
      kw[0] = pk2(kd[0], kd[1]); kw[1] = pk2(kd[2], kd[3]); kw[2] = pk2(kd[8], kd[9]); kw[3] = pk2(kd[10], kd[11]); kw[4] = pk2(kd[4], kd[5]); kw[5] = pk2(kd[6], kd[7]); kw[6] = pk2(kd[12], kd[13]); kw[7] = pk2(kd[14], kd[15]);
      const size_t toff = blk + (size_t)(c >> 1) * BW + (c & 1) * 64 + 16 * seg;
      if (!DRY) { *(v4u*)(GK + toff) = (v4u){kw[0], kw[1], kw[2], kw[3]}; *(v4u*)(GK + toff + 8) = (v4u){kw[4], kw[5], kw[6], kw[7]}; }
      else asm volatile("" :: "v"(kw[0]), "v"(kw[1]), "v"(kw[2]), "v"(kw[3]), "v"(kw[4]), "v"(kw[5]), "v"(kw[6]), "v"(kw[7]));
      if (!DRY && tid == 0) GLp[(size_t)(b * 4 + h) * NCH + n] = __builtin_amdgcn_exp2f(gl); }
    LDS_BARRIER();
    { const int row = tid >> 3, ch = (tid & 7) * 2; const size_t go = blk + (size_t)row * BW + ch * 8;
      const v4u q0 = *(const LAS v4u*)(lds + GL_QK + row * 256 + ch * 16), q1 = *(const LAS v4u*)(lds + GL_QK + row * 256 + ch * 16 + 16);
      const v4u w0 = *(const LAS v4u*)(lds + GL_KK + row * 256 + ch * 16), w1 = *(const LAS v4u*)(lds + GL_KK + row * 256 + ch * 16 + 16);
      if (!DRY) { *(v4u*)(GQ + go) = q0; *(v4u*)(GQ + go + 8) = q1; *(v4u*)(OW + go) = w0; *(v4u*)(OW + go + 8) = w1; }
      else asm volatile("" :: "v"(q0), "v"(q1), "v"(w0), "v"(w1)); }
    LDS_BARRIER();
}

constexpr int GC_NW = 0, GC_QD = 17408, GC_STR = 272;
constexpr int GC_UT = 34816, GC_KDT = GC_UT + 18432, GC_TSTR = 144;
constexpr int GC_AQ = GC_KDT + 18432;
constexpr int GC_GLW = GC_AQ + 9216;
constexpr int GC_OL = GC_GLW + 16, GC_OL_STRIDE = 132;
template <bool DRY = false>
__device__ __forceinline__ void gdn_chain(const bf16* GQ, const bf16* GK, const bf16* GV, bf16* OW, const bf16* AQK, const float* GLp, const float* onw, int b, int h, LAS unsigned char* lds, int tid) {
    asm volatile("" : "+v"(tid));
    const int wave = __builtin_amdgcn_readfirstlane(tid >> 6), lane = tid & 63, r32 = lane & 31, hi = lane >> 5;
    const int srow = tid >> 3, sch = (tid & 7) * 2;
    const size_t blk0 = ((size_t)b * TP) * BW + h * HD; const size_t soff = (size_t)srow * BW + sch * 8;
    const int ldq = srow * GC_STR + sch * 16, ldt = (2 * srow + (sch >> 3)) * GC_TSTR + (sch & 7) * 16;
    const size_t aq0 = ((size_t)b * TP) * 256 + h * 64 + (size_t)srow * 256 + (tid & 7) * 8; const int lda = srow * GC_TSTR + (tid & 7) * 16;
    const float* gl_c = GLp + (size_t)(b * 4 + h) * NCH;
    v4u pf[9]; float pg;
#define GC_LOAD(n) do { const size_t o_ = blk0 + (size_t)(n) * 64 * BW + soff; pf[0] = *(const v4u*)(OW + o_); pf[1] = *(const v4u*)(OW + o_ + 8); pf[2] = *(const v4u*)(GQ + o_); pf[3] = *(const v4u*)(GQ + o_ + 8); \
        pf[4] = *(const v4u*)(GV + o_); pf[5] = *(const v4u*)(GV + o_ + 8); pf[6] = *(const v4u*)(GK + o_); pf[7] = *(const v4u*)(GK + o_ + 8); pf[8] = *(const v4u*)(AQK + aq0 + (size_t)(n) * 64 * 256); pg = __hip_atomic_load(gl_c + (n), __ATOMIC_RELAXED, __HIP_MEMORY_SCOPE_AGENT); } while (0)
#define GC_STORE() do { *(LAS v4u*)(lds + GC_NW + ldq) = pf[0]; *(LAS v4u*)(lds + GC_NW + ldq + 16) = pf[1]; *(LAS v4u*)(lds + GC_QD + ldq) = pf[2]; *(LAS v4u*)(lds + GC_QD + ldq + 16) = pf[3]; \
        *(LAS v4u*)(lds + GC_UT + ldt) = pf[4]; *(LAS v4u*)(lds + GC_UT + ldt + 16) = pf[5]; *(LAS v4u*)(lds + GC_KDT + ldt) = pf[6]; *(LAS v4u*)(lds + GC_KDT + ldt + 16) = pf[7]; \
        *(LAS v4u*)(lds + GC_AQ + lda) = pf[8]; if (tid == 0) *(LAS float*)(lds + GC_GLW) = pg; } while (0)
    f32x16 sA[4] = {}; bf16x8 Sb[8];
#pragma unroll
    for (int k = 0; k < 8; ++k) Sb[k] = (bf16x8){0, 0, 0, 0, 0, 0, 0, 0};
    const int n0 = 32 * wave; const int ntok = tid >> 3, ncg = tid & 7;
    GC_LOAD(0); GC_STORE(); __syncthreads();
    for (int n = 0; n < NCH; ++n) {
        if (n + 1 < NCH) GC_LOAD(n + 1);
        if (wave < 4) {
            LAS float* OL = (LAS float*)(lds + GC_OL); const float gl = *(const LAS float*)(lds + GC_GLW);
            bf16x8 Vb[4];
#pragma unroll
            for (int mt = 0; mt < 2; ++mt) { f32x16 acc;
#pragma unroll
                for (int g = 0; g < 4; ++g) { const v2u w = *(const LAS v2u*)(lds + GC_UT + (n0 + r32) * GC_TSTR + (32 * mt + 8 * g + 4 * hi) * 2);
                    acc[4 * g] = bflo(w.x); acc[4 * g + 1] = bfhi(w.x); acc[4 * g + 2] = bflo(w.y); acc[4 * g + 3] = bfhi(w.y); }
#pragma unroll
                for (int ks = 0; ks < 8; ++ks) { const bf16x8 A = *(const LAS bf16x8*)(lds + GC_NW + (32 * mt + r32) * GC_STR + (16 * ks + 8 * hi) * 2);
                    acc = __builtin_amdgcn_mfma_f32_32x32x16_bf16(A, Sb[ks], acc, 0, 0, 0); }
#pragma unroll
                for (int s2 = 0; s2 < 2; ++s2) { v4u w; w.x = cvtpk(acc[8 * s2], acc[8 * s2 + 1]); w.y = cvtpk(acc[8 * s2 + 2], acc[8 * s2 + 3]); w.z = cvtpk(acc[8 * s2 + 4], acc[8 * s2 + 5]); w.w = cvtpk(acc[8 * s2 + 6], acc[8 * s2 + 7]);
                    Vb[2 * mt + s2] = __builtin_bit_cast(bf16x8, w); } }
#pragma unroll
            for (int mt = 0; mt < 2; ++mt) { f32x16 acc = {};
#pragma unroll
                for (int ks = 0; ks < 8; ++ks) { const bf16x8 A = *(const LAS bf16x8*)(lds + GC_QD + (32 * mt + r32) * GC_STR + (16 * ks + 8 * hi) * 2);
                    acc = __builtin_amdgcn_mfma_f32_32x32x16_bf16(A, Sb[ks], acc, 0, 0, 0); }
#pragma unroll
                for (int ks = 0; ks < 4; ++ks) { const bf16x8 A = *(const LAS bf16x8*)(lds + GC_AQ + (32 * mt + r32) * GC_TSTR + (16 * ks + 8 * hi) * 2);
                    acc = __builtin_amdgcn_mfma_f32_32x32x16_bf16(A, Vb[ks], acc, 0, 0, 0); }
#pragma unroll
                for (int r = 0; r < 16; ++r) OL[(32 * mt + 8 * (r >> 2) + 4 * hi + (r & 3)) * GC_OL_STRIDE + n0 + r32] = acc[r]; }
#pragma unroll
            for (int mt = 0; mt < 4; ++mt) { f32x16 acc;
#pragma unroll
                for (int r = 0; r < 16; ++r) acc[r] = sA[mt][r] * gl;
#pragma unroll
                for (int ks = 0; ks < 4; ++ks) { const bf16x8 A = *(const LAS bf16x8*)(lds + GC_KDT + (32 * mt + r32) * GC_TSTR + (16 * ks + 8 * hi) * 2);
                    acc = __builtin_amdgcn_mfma_f32_32x32x16_bf16(A, Vb[ks], acc, 0, 0, 0); }
                sA[mt] = acc; }
#pragma unroll
            for (int kt = 0; kt < 4; ++kt)
#pragma unroll
                for (int s2 = 0; s2 < 2; ++s2) { v4u w; w.x = cvtpk(sA[kt][8 * s2], sA[kt][8 * s2 + 1]); w.y = cvtpk(sA[kt][8 * s2 + 2], sA[kt][8 * s2 + 3]);
                    w.z = cvtpk(sA[kt][8 * s2 + 4], sA[kt][8 * s2 + 5]); w.w = cvtpk(sA[kt][8 * s2 + 6], sA[kt][8 * s2 + 7]); Sb[2 * kt + s2] = __builtin_bit_cast(bf16x8, w); }
        }
        __syncthreads();
        { const LAS float* OL = (const LAS float*)(lds + GC_OL) + ntok * GC_OL_STRIDE + 16 * ncg; f32x4 x[4]; float ss = 0.f;
#pragma unroll
          for (int j = 0; j < 4; ++j) { x[j] = *(const LAS f32x4*)(OL + 4 * j); ss += (x[j][0] * x[j][0] + x[j][1] * x[j][1]) + (x[j][2] * x[j][2] + x[j][3] * x[j][3]); }
          ss = red8(ss);
          const float rs = rsqrtf(ss * (1.f / HD) + EPS);
          f32x4 onv[4];
#pragma unroll
          for (int j = 0; j < 4; ++j) onv[j] = *(const f32x4*)(onw + 16 * ncg + 4 * j);
          v4u w0, w1; w0.x = pk2(x[0][0] * rs * onv[0][0], x[0][1] * rs * onv[0][1]); w0.y = pk2(x[0][2] * rs * onv[0][2], x[0][3] * rs * onv[0][3]); w0.z = pk2(x[1][0] * rs * onv[1][0], x[1][1] * rs * onv[1][1]); w0.w = pk2(x[1][2] * rs * onv[1][2], x[1][3] * rs * onv[1][3]);
          w1.x = pk2(x[2][0] * rs * onv[2][0], x[2][1] * rs * onv[2][1]); w1.y = pk2(x[2][2] * rs * onv[2][2], x[2][3] * rs * onv[2][3]); w1.z = pk2(x[3][0] * rs * onv[3][0], x[3][1] * rs * onv[3][1]); w1.w = pk2(x[3][2] * rs * onv[3][2], x[3][3] * rs * onv[3][3]);
          bf16* op = OW + blk0 + ((size_t)n * 64 + ntok) * BW + 16 * ncg; if (!DRY) { *(v4u*)op = w0; *(v4u*)(op + 8) = w1; } else asm volatile("" :: "v"(w0), "v"(w1)); }
        if (n + 1 < NCH) GC_STORE();
        __syncthreads();
    }
#undef GC_LOAD
#undef GC_STORE
}

constexpr int C2_ONW = 146688;
constexpr int H2_QE = 0, H2_KET = 17408, H2_VT = 35840, H2_OIT = 54272, H2_DEND = 72704, H2_OL = 73216, H2_XS = 107008;
template <int MH>
__device__ __forceinline__ void hg2_compute(LAS unsigned char* lds, f32x16 (&sA)[2], bf16x8 (&Sb)[8], int n0, int r32, int hi, int wave, int lane) {
    LAS float* OL = (LAS float*)(lds + H2_OL);
    { f32x16 acc;
#pragma unroll
      for (int g = 0; g < 4; ++g) { const v2u w = *(const LAS v2u*)(lds + H2_OIT + (n0 + r32) * 144 + (32 * MH + 8 * g + 4 * hi) * 2);
          acc[4 * g] = bflo(w.x); acc[4 * g + 1] = bfhi(w.x); acc[4 * g + 2] = bflo(w.y); acc[4 * g + 3] = bfhi(w.y); }
#pragma unroll
      for (int ks = 0; ks < 8; ++ks) { const bf16x8 A = *(const LAS bf16x8*)(lds + H2_QE + (32 * MH + r32) * 272 + (16 * ks + 8 * hi) * 2); acc = __builtin_amdgcn_mfma_f32_32x32x16_bf16(A, Sb[ks], acc, 0, 0, 0); }
#pragma unroll
      for (int r = 0; r < 16; ++r) OL[(32 * MH + 8 * (r >> 2) + 4 * hi + (r & 3)) * 132 + n0 + r32] = acc[r]; }
    bf16x8 Vf[4];
#pragma unroll
    for (int ks = 0; ks < 4; ++ks) Vf[ks] = *(const LAS bf16x8*)(lds + H2_VT + (n0 + r32) * 144 + (16 * ks + 8 * hi) * 2);
#pragma unroll
    for (int t = 0; t < 2; ++t) { const int mt = 2 * MH + t; f32x16 acc;
#pragma unroll
        for (int g = 0; g < 4; ++g) { const f32x4 dv = *(const LAS f32x4*)(lds + H2_DEND + (32 * mt + 8 * g + 4 * hi) * 4);
#pragma unroll
            for (int i = 0; i < 4; ++i) acc[4 * g + i] = sA[t][4 * g + i] * dv[i]; }
#pragma unroll
        for (int ks = 0; ks < 4; ++ks) { const bf16x8 A = *(const LAS bf16x8*)(lds + H2_KET + (32 * mt + r32) * 144 + (16 * ks + 8 * hi) * 2); acc = __builtin_amdgcn_mfma_f32_32x32x16_bf16(A, Vf[ks], acc, 0, 0, 0); }
        sA[t] = acc;
#pragma unroll
        for (int s2 = 0; s2 < 2; ++s2) { v4u w; w.x = cvtpk(acc[8 * s2], acc[8 * s2 + 1]); w.y = cvtpk(acc[8 * s2 + 2], acc[8 * s2 + 3]); w.z = cvtpk(acc[8 * s2 + 4], acc[8 * s2 + 5]); w.w = cvtpk(acc[8 * s2 + 6], acc[8 * s2 + 7]);
            Sb[4 * MH + 2 * t + s2] = __builtin_bit_cast(bf16x8, w); *(LAS v4u*)(lds + H2_XS + wave * 4096 + (2 * t + s2) * 1024 + lane * 16) = w; } }
}
template <bool DRY = false>
__device__ __forceinline__ void hg_chain2(const bf16* HQ, const bf16* HF, const bf16* HI, bf16* OH, const float* DEND, const float* onw, int b, int h, LAS unsigned char* lds, int tid, int nb, int ne, bool first) {
    asm volatile("" : "+v"(tid));
    const int wave = __builtin_amdgcn_readfirstlane(tid >> 6), lane = tid & 63, r32 = lane & 31, hi = lane >> 5, mh = wave >> 2, n0 = 32 * (wave & 3);
    const int srow = tid >> 3, sch = (tid & 7) * 2;
    const size_t blk0 = ((size_t)b * TP) * BW + h * HD; const size_t soff = (size_t)srow * BW + sch * 8;
    const int ldq = srow * 272 + sch * 16, ldt = (2 * srow + (sch >> 3)) * 144 + (sch & 7) * 16;
    const float* dend_c = DEND + (size_t)(b * 4 + h) * NCH * 128;
    v4u pf[8]; f32x4 pd;
#define H2_LOAD(n) do { const size_t o_ = blk0 + (size_t)(n) * 64 * BW + soff; pf[0] = *(const v4u*)(HQ + o_); pf[1] = *(const v4u*)(HQ + o_ + 8); pf[2] = *(const v4u*)(HF + o_); pf[3] = *(const v4u*)(HF + o_ + 8); \
        pf[4] = *(const v4u*)(HI + o_); pf[5] = *(const v4u*)(HI + o_ + 8); pf[6] = *(const v4u*)(OH + o_); pf[7] = *(const v4u*)(OH + o_ + 8); pd = *(const f32x4*)(dend_c + (size_t)(n) * 128 + 4 * (tid & 31)); } while (0)
#define H2_STORE() do { *(LAS v4u*)(lds + H2_QE + ldq) = pf[0]; *(LAS v4u*)(lds + H2_QE + ldq + 16) = pf[1]; *(LAS v4u*)(lds + H2_KET + ldt) = pf[2]; *(LAS v4u*)(lds + H2_KET + ldt + 16) = pf[3]; \
        *(LAS v4u*)(lds + H2_VT + ldt) = pf[4]; *(LAS v4u*)(lds + H2_VT + ldt + 16) = pf[5]; *(LAS v4u*)(lds + H2_OIT + ldt) = pf[6]; *(LAS v4u*)(lds + H2_OIT + ldt + 16) = pf[7]; \
        if (tid < 32) *(LAS f32x4*)(lds + H2_DEND + 16 * tid) = pd; } while (0)
    bf16x8 Sb[8]; f32x16 sA[2];
    if (first) { unsigned z0; asm volatile("v_mov_b32 %0, 0" : "=v"(z0)); for (int u = tid; u < 32768 / 16; u += 512) *(LAS v4u*)(lds + H2_XS + u * 16) = (v4u){z0, z0, z0, z0};
#pragma unroll
        for (int t = 0; t < 2; ++t) sA[t] = (f32x16){}; }
    else {
#pragma unroll
        for (int t = 0; t < 2; ++t)
#pragma unroll
            for (int r = 0; r < 16; ++r) sA[t][r] = *(const LAS float*)(lds + ((wave * 2 + t) * 16 + r) * 256 + lane * 4);
        LDS_BARRIER(); }
    const int ntok = tid >> 3, ncg = tid & 7;
    if (tid < 32) *(LAS f32x4*)(lds + C2_ONW + 16 * tid) = *(const f32x4*)(onw + 4 * tid);
    H2_LOAD(nb); H2_STORE(); H2_LOAD((nb + 1 < ne ? nb + 1 : ne - 1)); __syncthreads();
#pragma unroll
    for (int k = 0; k < 8; ++k) Sb[k] = *(const LAS bf16x8*)(lds + H2_XS + ((k >> 2) * 4 + (wave & 3)) * 4096 + (k & 3) * 1024 + lane * 16);
    for (int n = nb; n < ne; ++n) {
        if (mh == 0) hg2_compute<0>(lds, sA, Sb, n0, r32, hi, wave, lane); else hg2_compute<1>(lds, sA, Sb, n0, r32, hi, wave, lane);
        LDS_BARRIER();
        { const LAS float* OL = (const LAS float*)(lds + H2_OL) + ntok * 132 + 16 * ncg; f32x4 x[4]; float ss = 0.f;
#pragma unroll
          for (int j = 0; j < 4; ++j) { x[j] = *(const LAS f32x4*)(OL + 4 * j); ss += (x[j][0] * x[j][0] + x[j][1] * x[j][1]) + (x[j][2] * x[j][2] + x[j][3] * x[j][3]); }
          ss = red8(ss);
          const float rs = rsqrtf(ss * (1.f / HD) + EPS);
          f32x4 onv[4];
#pragma unroll
          for (int j = 0; j < 4; ++j) onv[j] = *(const LAS f32x4*)(lds + C2_ONW + (16 * ncg + 4 * j) * 4);
          v4u w0, w1; w0.x = pk2(x[0][0] * rs * onv[0][0], x[0][1] * rs * onv[0][1]); w0.y = pk2(x[0][2] * rs * onv[0][2], x[0][3] * rs * onv[0][3]); w0.z = pk2(x[1][0] * rs * onv[1][0], x[1][1] * rs * onv[1][1]); w0.w = pk2(x[1][2] * rs * onv[1][2], x[1][3] * rs * onv[1][3]);
          w1.x = pk2(x[2][0] * rs * onv[2][0], x[2][1] * rs * onv[2][1]); w1.y = pk2(x[2][2] * rs * onv[2][2], x[2][3] * rs * onv[2][3]); w1.z = pk2(x[3][0] * rs * onv[3][0], x[3][1] * rs * onv[3][1]); w1.w = pk2(x[3][2] * rs * onv[3][2], x[3][3] * rs * onv[3][3]);
          bf16* op = OH + blk0 + ((size_t)n * 64 + ntok) * BW + 16 * ncg; if (!DRY) { *(v4u*)op = w0; *(v4u*)(op + 8) = w1; } else asm volatile("" :: "v"(w0), "v"(w1)); }
        H2_STORE(); H2_LOAD((n + 2 < ne ? n + 2 : ne - 1));
        if (mh == 0) {
#pragma unroll
            for (int j = 0; j < 4; ++j) Sb[4 + j] = *(const LAS bf16x8*)(lds + H2_XS + (wave ^ 4) * 4096 + j * 1024 + lane * 16); }
        else {
#pragma unroll
            for (int j = 0; j < 4; ++j) Sb[j] = *(const LAS bf16x8*)(lds + H2_XS + (wave ^ 4) * 4096 + j * 1024 + lane * 16); }
        LDS_BARRIER();
    }
#pragma unroll
    for (int t = 0; t < 2; ++t)
#pragma unroll
        for (int r = 0; r < 16; ++r) *(LAS float*)(lds + ((wave * 2 + t) * 16 + r) * 256 + lane * 4) = sA[t][r];
    LDS_BARRIER();
#undef H2_LOAD
#undef H2_STORE
}

constexpr int G2_NW = 0, G2_QD = 17408, G2_UT = 34816, G2_KDT = 53248, G2_AQ = 71680, G2_GLW = 80896, G2_OLT = 80912, G2_XS = 113680;
#define G2_SFRAG(ks) (*(const LAS bf16x8*)(lds + G2_XS + (((ks) >> 2) * 4 + nq) * 4096 + ((ks) & 3) * 1024 + lane * 16))
template <int MH>
__device__ __forceinline__ void gdn2_a(LAS unsigned char* lds, f32x16& oacc, bf16x8 (&Vb)[4], int nq, int r32, int hi, int wave, int lane) {
    const int n0 = 32 * nq;
    f32x16 acc;
#pragma unroll
    for (int g = 0; g < 4; ++g) { const v2u w = *(const LAS v2u*)(lds + G2_UT + (n0 + r32) * 144 + (32 * MH + 8 * g + 4 * hi) * 2);
        acc[4 * g] = bflo(w.x); acc[4 * g + 1] = bfhi(w.x); acc[4 * g + 2] = bflo(w.y); acc[4 * g + 3] = bfhi(w.y); }
    oacc = (f32x16){};
#pragma unroll
    for (int ks = 0; ks < 8; ++ks) { const bf16x8 Bs = G2_SFRAG(ks);
        const bf16x8 A = *(const LAS bf16x8*)(lds + G2_NW + (32 * MH + r32) * 272 + (16 * ks + 8 * hi) * 2); acc = __builtin_amdgcn_mfma_f32_32x32x16_bf16(A, Bs, acc, 0, 0, 0);
        const bf16x8 A2 = *(const LAS bf16x8*)(lds + G2_QD + (32 * MH + r32) * 272 + (16 * ks + 8 * hi) * 2); oacc = __builtin_amdgcn_mfma_f32_32x32x16_bf16(A2, Bs, oacc, 0, 0, 0);
        if ((ks & 1) == 1) SBAR(); }
#pragma unroll
    for (int s2 = 0; s2 < 2; ++s2) { v4u w; w.x = cvtpk(acc[8 * s2], acc[8 * s2 + 1]); w.y = cvtpk(acc[8 * s2 + 2], acc[8 * s2 + 3]); w.z = cvtpk(acc[8 * s2 + 4], acc[8 * s2 + 5]); w.w = cvtpk(acc[8 * s2 + 6], acc[8 * s2 + 7]);
        Vb[2 * MH + s2] = __builtin_bit_cast(bf16x8, w); *(LAS v4u*)(lds + G2_OLT + (wave ^ 4) * 4096 + s2 * 1024 + lane * 16) = w; }
}
template <int MH>
__device__ __forceinline__ void gdn2_bc(LAS unsigned char* lds, f32x16& oacc, f32x16 (&sA)[2], bf16x8 (&Vb)[4], int nq, int r32, int hi, int wave, int lane) {
#pragma unroll
    for (int s2 = 0; s2 < 2; ++s2) Vb[2 * (1 - MH) + s2] = *(const LAS bf16x8*)(lds + G2_OLT + wave * 4096 + s2 * 1024 + lane * 16);
#pragma unroll
    for (int ks = 0; ks < 4; ++ks) { const bf16x8 A = *(const LAS bf16x8*)(lds + G2_AQ + (32 * MH + r32) * 144 + (16 * ks + 8 * hi) * 2); oacc = __builtin_amdgcn_mfma_f32_32x32x16_bf16(A, Vb[ks], oacc, 0, 0, 0); }
    { LAS float* OT = (LAS float*)(lds + G2_OLT + wave * 4096);
#pragma unroll
      for (int r = 0; r < 16; ++r) OT[(8 * (r >> 2) + 4 * hi + (r & 3)) * 32 + r32] = oacc[r]; }
    const float gl = *(const LAS float*)(lds + G2_GLW);
#pragma unroll
    for (int t = 0; t < 2; ++t) { const int mt = 2 * MH + t; f32x16 acc;
#pragma unroll
        for (int r = 0; r < 16; ++r) acc[r] = sA[t][r] * gl;
#pragma unroll
        for (int ks = 0; ks < 4; ++ks) { const bf16x8 A = *(const LAS bf16x8*)(lds + G2_KDT + (32 * mt + r32) * 144 + (16 * ks + 8 * hi) * 2); acc = __builtin_amdgcn_mfma_f32_32x32x16_bf16(A, Vb[ks], acc, 0, 0, 0); }
        sA[t] = acc;
#pragma unroll
        for (int s2 = 0; s2 < 2; ++s2) { v4u w; w.x = cvtpk(acc[8 * s2], acc[8 * s2 + 1]); w.y = cvtpk(acc[8 * s2 + 2], acc[8 * s2 + 3]); w.z = cvtpk(acc[8 * s2 + 4], acc[8 * s2 + 5]); w.w = cvtpk(acc[8 * s2 + 6], acc[8 * s2 + 7]);
            *(LAS v4u*)(lds + G2_XS + wave * 4096 + (2 * t + s2) * 1024 + lane * 16) = w; } }
}
template <bool DRY = false, int MODE = 3>
__device__ __forceinline__ void gdn_chain2(const bf16* GQ, const bf16* GK, const bf16* GV, bf16* OW, const bf16* AQK, const float* GLp, const float* onw, int b, int h, LAS unsigned char* lds, int tid, int nb, int ne, bool first) {
    asm volatile("" : "+v"(tid));
    const int wave = __builtin_amdgcn_readfirstlane(tid >> 6), lane = tid & 63, r32 = lane & 31, hi = lane >> 5, mh = wave >> 2;
    const size_t blk0 = ((size_t)b * TP) * BW + h * HD;
    const float* gl_c = GLp + (size_t)(b * 4 + h) * NCH;
    v4u pfA[9], pfB[9]; float pgA, pgB;
#define G2_ADDR int t_ = tid; asm volatile("" : "+v"(t_)); const int srow = t_ >> 3, sch = (t_ & 7) * 2; const size_t soff = (size_t)srow * BW + sch * 8; \
        const int ldq = srow * 272 + sch * 16, ldt = (2 * srow + (sch >> 3)) * 144 + (sch & 7) * 16; const size_t aq0 = ((size_t)b * TP) * 256 + h * 64 + (size_t)srow * 256 + (t_ & 7) * 8; const int lda = srow * 144 + (t_ & 7) * 16; \
        (void)soff; (void)ldq; (void)ldt; (void)aq0; (void)lda;
#define G2_LOAD(pf, pg, n) do { G2_ADDR const size_t o_ = blk0 + (size_t)(n) * 64 * BW + soff; pf[0] = *(const v4u*)(OW + o_); pf[1] = *(const v4u*)(OW + o_ + 8); pf[2] = *(const v4u*)(GV + o_); pf[3] = *(const v4u*)(GV + o_ + 8); \
        pf[4] = *(const v4u*)(GQ + o_); pf[5] = *(const v4u*)(GQ + o_ + 8); pf[6] = *(const v4u*)(GK + o_); pf[7] = *(const v4u*)(GK + o_ + 8); pf[8] = *(const v4u*)(AQK + aq0 + (size_t)(n) * 64 * 256); \
        pg = __hip_atomic_load(gl_c + (n), __ATOMIC_RELAXED, __HIP_MEMORY_SCOPE_AGENT); } while (0)
#define G2_STORE1(pf) do { G2_ADDR *(LAS v4u*)(lds + G2_NW + ldq) = pf[0]; *(LAS v4u*)(lds + G2_NW + ldq + 16) = pf[1]; *(LAS v4u*)(lds + G2_UT + ldt) = pf[2]; *(LAS v4u*)(lds + G2_UT + ldt + 16) = pf[3]; } while (0)
#define G2_STORE2(pf, pg) do { G2_ADDR *(LAS v4u*)(lds + G2_QD + ldq) = pf[4]; *(LAS v4u*)(lds + G2_QD + ldq + 16) = pf[5]; *(LAS v4u*)(lds + G2_KDT + ldt) = pf[6]; *(LAS v4u*)(lds + G2_KDT + ldt + 16) = pf[7]; \
        *(LAS v4u*)(lds + G2_AQ + lda) = pf[8]; if (t_ == 0) *(LAS float*)(lds + G2_GLW) = pg; } while (0)
    bf16x8 Vb[4]; f32x16 oacc; const int nq = wave & 3; f32x16 sA[2];
    if (first) { unsigned z0; asm volatile("v_mov_b32 %0, 0" : "=v"(z0)); for (int u = tid; u < 32768 / 16; u += 512) *(LAS v4u*)(lds + G2_XS + u * 16) = (v4u){z0, z0, z0, z0};
#pragma unroll
        for (int t = 0; t < 2; ++t) sA[t] = (f32x16){}; }
    else {
#pragma unroll
        for (int t = 0; t < 2; ++t)
#pragma unroll
            for (int r = 0; r < 16; ++r) sA[t][r] = *(const LAS float*)(lds + ((wave * 2 + t) * 16 + r) * 256 + lane * 4);
        LDS_BARRIER(); }
    const int ntok = tid >> 3, ncg = tid & 7;
    if (tid < 32) *(LAS f32x4*)(lds + C2_ONW + 16 * tid) = *(const f32x4*)(onw + 4 * tid);
    G2_LOAD(pfA, pgA, nb); G2_STORE1(pfA); G2_STORE2(pfA, pgA); G2_LOAD(pfA, pgA, nb + 1); G2_LOAD(pfB, pgB, (nb + 2 < ne ? nb + 2 : ne - 1)); __syncthreads();
#define G2_ITER(n, pf, pg) do { \
        if (MODE & 1) { if (mh == 0) gdn2_a<0>(lds, oacc, Vb, nq, r32, hi, wave, lane); else gdn2_a<1>(lds, oacc, Vb, nq, r32, hi, wave, lane); } \
        LDS_BARRIER(); \
        if (MODE & 2) G2_STORE1(pf); \
        if (MODE & 1) { if (mh == 0) gdn2_bc<0>(lds, oacc, sA, Vb, nq, r32, hi, wave, lane); else gdn2_bc<1>(lds, oacc, sA, Vb, nq, r32, hi, wave, lane); } \
        LDS_BARRIER(); \
        if (MODE & 2) { const LAS float* OL = (const LAS float*)(lds + G2_OLT + ((ntok >> 5) * 4 + (ncg >> 1)) * 4096) + (ntok & 31) * 32 + (ncg & 1) * 16; f32x4 x[4]; float ss = 0.f; \
          _Pragma("unroll") for (int j = 0; j < 4; ++j) { x[j] = *(const LAS f32x4*)(OL + 4 * j); ss += (x[j][0] * x[j][0] + x[j][1] * x[j][1]) + (x[j][2] * x[j][2] + x[j][3] * x[j][3]); } \
          ss = red8(ss); \
          const float rs = rsqrtf(ss * (1.f / HD) + EPS); \
          f32x4 onv[4]; \
          _Pragma("unroll") for (int j = 0; j < 4; ++j) onv[j] = *(const LAS f32x4*)(lds + C2_ONW + (16 * ncg + 4 * j) * 4); \
          v4u w0, w1; w0.x = pk2(x[0][0] * rs * onv[0][0], x[0][1] * rs * onv[0][1]); w0.y = pk2(x[0][2] * rs * onv[0][2], x[0][3] * rs * onv[0][3]); w0.z = pk2(x[1][0] * rs * onv[1][0], x[1][1] * rs * onv[1][1]); w0.w = pk2(x[1][2] * rs * onv[1][2], x[1][3] * rs * onv[1][3]); \
          w1.x = pk2(x[2][0] * rs * onv[2][0], x[2][1] * rs * onv[2][1]); w1.y = pk2(x[2][2] * rs * onv[2][2], x[2][3] * rs * onv[2][3]); w1.z = pk2(x[3][0] * rs * onv[3][0], x[3][1] * rs * onv[3][1]); w1.w = pk2(x[3][2] * rs * onv[3][2], x[3][3] * rs * onv[3][3]); \
          bf16* op = OW + blk0 + ((size_t)(n) * 64 + ntok) * BW + 16 * ncg; if (!DRY) { *(v4u*)op = w0; *(v4u*)(op + 8) = w1; } else asm volatile("" :: "v"(w0), "v"(w1)); } \
        if (MODE & 2) { G2_STORE2(pf, pg); G2_LOAD(pf, pg, ((n) + 3 < ne ? (n) + 3 : ne - 1)); } \
        LDS_BARRIER(); } while (0)
    for (int n = nb; n < ne; n += 2) { G2_ITER(n, pfA, pgA); G2_ITER(n + 1, pfB, pgB); }
#pragma unroll
    for (int t = 0; t < 2; ++t)
#pragma unroll
        for (int r = 0; r < 16; ++r) *(LAS float*)(lds + ((wave * 2 + t) * 16 + r) * 256 + lane * 4) = sA[t][r];
    LDS_BARRIER();
#undef G2_ITER
#undef G2_LOAD
#undef G2_ADDR
#undef G2_STORE1
#undef G2_STORE2
}

__device__ __forceinline__ void sb_naive_item(const bf16* Q, const bf16* K, const bf16* V, bf16* O, const float* qn, const float* kn, int b, int h, int blk, int tid) {
    const int qi = tid >> 2, part = tid & 3; const int t = blk * 128 + qi; const size_t rb = (size_t)b * TP; const int cb = h * HD + part * 32;
    float qt[32], acc[32];
    { const v4u* qp = (const v4u*)(Q + (rb + t) * BW + cb); float ss = 0.f;
#pragma unroll
      for (int j = 0; j < 4; ++j) { const v4u w = qp[j]; qt[8 * j + 0] = bflo(w.x); qt[8 * j + 1] = bfhi(w.x); qt[8 * j + 2] = bflo(w.y); qt[8 * j + 3] = bfhi(w.y); qt[8 * j + 4] = bflo(w.z); qt[8 * j + 5] = bfhi(w.z); qt[8 * j + 6] = bflo(w.w); qt[8 * j + 7] = bfhi(w.w); }
#pragma unroll
      for (int j = 0; j < 32; ++j) ss += qt[j] * qt[j];
      ss = red4(ss);
      const float rq = rsqrtf(ss * (1.f / HD) + EPS) * QSCALE;
#pragma unroll
      for (int j = 0; j < 32; ++j) { qt[j] *= rq * qn[part * 32 + j] * kn[part * 32 + j]; acc[j] = 0.f; } }
    float run = 0.f;
    const int tmax = blk * 128 + (tid >> 6) * 16 + 15;
    for (int s = tmax - 1; s >= PADF; --s) {
        const v4u* kp = (const v4u*)(K + (rb + s) * BW + cb); float d = 0.f, kk = 0.f;
#pragma unroll
        for (int j = 0; j < 4; ++j) { const v4u w = kp[j]; const float k0 = bflo(w.x), k1 = bfhi(w.x), k2 = bflo(w.y), k3 = bfhi(w.y), k4 = bflo(w.z), k5 = bfhi(w.z), k6 = bflo(w.w), k7 = bfhi(w.w);
            d += qt[8 * j] * k0 + qt[8 * j + 1] * k1 + qt[8 * j + 2] * k2 + qt[8 * j + 3] * k3 + qt[8 * j + 4] * k4 + qt[8 * j + 5] * k5 + qt[8 * j + 6] * k6 + qt[8 * j + 7] * k7;
            kk += k0 * k0 + k1 * k1 + k2 * k2 + k3 * k3 + k4 * k4 + k5 * k5 + k6 * k6 + k7 * k7; }
        d = red4(d); kk = red4(kk);
        const float z = d * rsqrtf(kk * (1.f / HD) + EPS); const float sp = softplusf_(z);
        if (s < t) { const float a = __expf(z - sp - run); run += sp; const v4u* vp = (const v4u*)(V + (rb + s) * BW + cb);
#pragma unroll
            for (int j = 0; j < 4; ++j) { const v4u w = vp[j]; acc[8 * j] += a * bflo(w.x); acc[8 * j + 1] += a * bfhi(w.x); acc[8 * j + 2] += a * bflo(w.y); acc[8 * j + 3] += a * bfhi(w.y);
                acc[8 * j + 4] += a * bflo(w.z); acc[8 * j + 5] += a * bfhi(w.z); acc[8 * j + 6] += a * bflo(w.w); acc[8 * j + 7] += a * bfhi(w.w); } }
    }
    v4u* op = (v4u*)(O + (rb + t) * BW + cb);
#pragma unroll
    for (int j = 0; j < 4; ++j) { v4u w; w.x = pk2(acc[8 * j], acc[8 * j + 1]); w.y = pk2(acc[8 * j + 2], acc[8 * j + 3]); w.z = pk2(acc[8 * j + 4], acc[8 * j + 5]); w.w = pk2(acc[8 * j + 6], acc[8 * j + 7]); op[j] = w; }
}
__device__ __forceinline__ void gdn_naive_chain(const bf16* GQ, const bf16* GK, const bf16* GV, bf16* O, const float* convw, const float* BETA, const float* GG, const float* onw, int b, int h, LAS float* sh, int tid) {
    const int e = tid >> 2, part = tid & 3, lane = tid & 63, wave = tid >> 6;
    float S[32];
#pragma unroll
    for (int j = 0; j < 32; ++j) S[j] = 0.f;
    const float onwe = onw[e];
    for (int t = 0; t < TP; ++t) {
        const size_t m = (size_t)b * TP + t;
        if (tid < 384) { const int which = tid >> 7, c = tid & 127, col = h * HD + c; const bf16* src = which == 0 ? GQ : (which == 1 ? GK : GV);
            float a = 0.f;
#pragma unroll
            for (int i = 0; i < 4; ++i) { const int tt = t - 3 + i; if (tt >= 0) a += bf2f(src[((size_t)b * TP + tt) * BW + col]) * convw[i * 1536 + which * 512 + col]; }
            sh[tid] = a * sigmoidf_(a); }
        __syncthreads();
        if (wave < 2) { const float x0 = sh[wave * 128 + lane], x1 = sh[wave * 128 + 64 + lane]; const float s = wave_sum(x0 * x0 + x1 * x1); if (lane == 0) sh[384 + wave] = rsqrtf(s + EPS); }
        __syncthreads();
        const float rq = sh[384] * QSCALE, rk = sh[385]; const float beta = BETA[m * 4 + h], eg = __expf(GG[m * 4 + h]);
        float ks = 0.f;
#pragma unroll
        for (int j = 0; j < 32; ++j) ks += sh[128 + part * 32 + j] * S[j];
        ks *= rk; ks = red4(ks);
        const float vn = beta * (sh[256 + e] - eg * ks) * rk;
        float o = 0.f;
#pragma unroll
        for (int j = 0; j < 32; ++j) { S[j] = eg * S[j] + sh[128 + part * 32 + j] * vn; o += sh[part * 32 + j] * S[j]; }
        o *= rq; o = red4(o);
        if (part == 0) sh[392 + e] = o;
        __syncthreads();
        if (wave == 0) { const float x0 = sh[392 + lane], x1 = sh[392 + 64 + lane]; const float s = wave_sum(x0 * x0 + x1 * x1); if (lane == 0) sh[386] = rsqrtf(s * (1.f / HD) + EPS); }
        __syncthreads();
        if (part == 0) O[m * BW + h * HD + e] = (bf16)f2bf(o * sh[386] * onwe);
    }
}
__device__ __forceinline__ void hg_naive_chain(const bf16* HQ, const bf16* HF, const bf16* HI, bf16* O, const float* lb, const float* onw, int b, int h, LAS float* sh, int tid) {
    const int e = tid >> 2, part = tid & 3, lane = tid & 63, wave = tid >> 6;
    float S[32];
#pragma unroll
    for (int j = 0; j < 32; ++j) S[j] = 0.f;
    const float onwe = onw[e];
    for (int t = 0; t < TP; ++t) {
        const size_t m = (size_t)b * TP + t;
        if (tid < 128) { const float x = bf2f(HQ[m * BW + h * HD + tid]); sh[tid] = x * sigmoidf_(x); }
        else if (tid < 256) { const int c = tid - 128; const float fp = bf2f(HF[m * BW + h * HD + c]); const float l = lb[h * HD + c]; sh[128 + c] = l + (1.f - l) * sigmoidf_(fp); sh[256 + c] = (1.f - l) * sigmoidf_(-fp); }
        else if (tid < 384) { const int c = tid - 256; sh[384 + c] = (t >= PADF) ? bf2f(HI[m * BW + h * HD + c]) : 0.f; }
        __syncthreads();
        const float ve = sh[384 + e]; float o = 0.f;
#pragma unroll
        for (int j = 0; j < 32; ++j) { S[j] = sh[128 + part * 32 + j] * S[j] + sh[256 + part * 32 + j] * ve; o += sh[part * 32 + j] * S[j]; }
        o = red4(o);
        if (part == 0) sh[520 + e] = o;
        __syncthreads();
        if (wave == 0) { const float x0 = sh[520 + lane], x1 = sh[520 + 64 + lane]; const float s = wave_sum(x0 * x0 + x1 * x1); if (lane == 0) sh[512] = rsqrtf(s * (1.f / HD) + EPS); }
        __syncthreads();
        if (part == 0) O[m * BW + h * HD + e] = (bf16)f2bf(o * sh[512] * onwe);
        __syncthreads();
    }
}

constexpr int FRONT_MODE = 31;
constexpr int MREAL = NB * TREAL;
__device__ __forceinline__ f32x4 skinny_tile(const bf16* A, int lda, const bf16* Bt, int K, int tile, int lane) {
    const int fr = lane & 15, fq = lane >> 4; f32x4 acc = {0.f, 0.f, 0.f, 0.f};
    const bf16* ap = A + (size_t)fr * lda + 8 * fq; const bf16* bp = Bt + (size_t)(16 * tile + fr) * K + 8 * fq;
    for (int k0 = 0; k0 < K / 32; k0 += 8) {
        bf16x8 a8[8], b8[8];
#pragma unroll
        for (int j = 0; j < 8; ++j) { a8[j] = *(const bf16x8*)(ap + 32 * (k0 + j)); b8[j] = *(const bf16x8*)(bp + 32 * (k0 + j)); }
#pragma unroll
        for (int j = 0; j < 8; ++j) acc = __builtin_amdgcn_mfma_f32_16x16x32_bf16(a8[j], b8[j], acc, 0, 0, 0); }
    return acc;
}

template <int NKS>
__device__ __forceinline__ f32x4 skinny_part(const bf16* A, int lda, const bf16* Bt, int K, int tile, int lane, int ks0) {
    const int fr = lane & 15, fq = lane >> 4; f32x4 acc = {0.f, 0.f, 0.f, 0.f};
    const bf16* ap = A + (size_t)fr * lda + 8 * fq + 32 * ks0; const bf16* bp = Bt + (size_t)(16 * tile + fr) * K + 8 * fq + 32 * ks0;
    constexpr int BT = NKS < 8 ? NKS : 8;
#pragma unroll
    for (int k0 = 0; k0 < NKS; k0 += BT) { bf16x8 a8[BT], b8[BT];
#pragma unroll
        for (int j = 0; j < BT; ++j) { a8[j] = *(const bf16x8*)(ap + 32 * (k0 + j)); b8[j] = *(const bf16x8*)(bp + 32 * (k0 + j)); }
#pragma unroll
        for (int j = 0; j < BT; ++j) acc = __builtin_amdgcn_mfma_f32_16x16x32_bf16(a8[j], b8[j], acc, 0, 0, 0); }
    return acc;
}

#define PHASE_LOCALS \
    const int tid = (wave_s << 6) + fresh_lane(); \
    const int lane = tid & 63, wave = wave_s; \
    const __attribute__((address_space(4))) Args* ap = (const __attribute__((address_space(4))) Args*)__builtin_amdgcn_kernarg_segment_ptr(); asm volatile("" : "+s"(ap)); \
    GLOBAL_AS unsigned char* wsg_ = (GLOBAL_AS unsigned char*)ap->ws; asm volatile("" : "+s"(wsg_)); unsigned char* ws = (unsigned char*)wsg_; \
    const int gw = blockIdx.x * 8 + wave, NGW = G * 8; (void)lane; (void)gw; (void)NGW; \
    float* FRONT = (float*)(ws + WS_FRONT); float* BETA = (float*)(ws + WS_BETA); float* GGp = (float*)(ws + WS_GG); \
    float* LB = (float*)(ws + WS_LB); float* WBA = (float*)(ws + WS_WBA); \
    bf16* XN = (bf16*)(ws + WS_XN); bf16* ARR = (bf16*)(ws + WS_ARR); bf16* OARR = (bf16*)(ws + WS_O); \
    bf16* Wt_in = (bf16*)(ws + WS_W); bf16* Wt_B = (bf16*)((unsigned char*)Wt_in + W_IN_BYTES); bf16* Wt_O = (bf16*)((unsigned char*)Wt_in + W_IN_BYTES + W_B_BYTES); \
    float* hin_big = layer == 0 ? (float*)gp(ap->x) : gp(ap->out); \
    (void)FRONT; (void)BETA; (void)GGp; (void)LB; (void)WBA; (void)XN; (void)ARR; (void)OARR; (void)Wt_in; (void)Wt_B; (void)Wt_O; (void)hin_big;
constexpr size_t ASZ = (size_t)R * BW;

template <int NR>
__device__ __forceinline__ void p1_rows(float* FRONT, float* hin_big, bf16* XN, float* BETA, float* GGp, const float* nw, const float* wba, const float* alg, const float* dtb, int m0, int lane) {
    f32x4 v[NR][4]; float rs[NR];
#pragma unroll
    for (int r = 0; r < NR; ++r) { const float* hr = hrow(FRONT, hin_big, m0 + r);
#pragma unroll
        for (int j = 0; j < 4; ++j) v[r][j] = *(const f32x4*)(hr + 4 * lane + 256 * j); }
#pragma unroll
    for (int r = 0; r < NR; ++r) { float ss = 0.f;
#pragma unroll
        for (int j = 0; j < 4; ++j) ss += (v[r][j].x * v[r][j].x + v[r][j].y * v[r][j].y) + (v[r][j].z * v[r][j].z + v[r][j].w * v[r][j].w);
        rs[r] = ss; }
#pragma unroll
    for (int r = 0; r < NR; ++r) rs[r] = rsqrtf(wave_sum(rs[r]) * (1.f / DM) + EPS);
#pragma unroll
    for (int j = 0; j < 4; ++j) { const f32x4 nwv = *(const f32x4*)(nw + 4 * lane + 256 * j);
#pragma unroll
        for (int r = 0; r < NR; ++r) { v[r][j] = v[r][j] * rs[r] * nwv; v2u o; o.x = pk2(v[r][j].x, v[r][j].y); o.y = pk2(v[r][j].z, v[r][j].w); *(v2u*)(XN + (size_t)(m0 + r) * DM + 4 * lane + 256 * j) = o; } }
    float db[NR], da[NR];
#pragma unroll
    for (int r = 0; r < NR; ++r) { db[r] = 0.f; da[r] = 0.f; }
#pragma unroll
    for (int c = 0; c < 8; ++c) { f32x4 w[4];
#pragma unroll
        for (int j = 0; j < 4; ++j) w[j] = *(const f32x4*)(wba + c * DM + 4 * lane + 256 * j);
#pragma unroll
        for (int r = 0; r < NR; ++r) { float d = 0.f;
#pragma unroll
            for (int j = 0; j < 4; ++j) d += (v[r][j].x * w[j].x + v[r][j].y * w[j].y) + (v[r][j].z * w[j].z + v[r][j].w * w[j].w);
            d = wave_sum(d);
            if (c < 4) db[r] = lane == c ? d : db[r]; else da[r] = lane == c - 4 ? d : da[r]; } }
    if (lane < 4) { const float ae = -__expf(alg[lane]), bias = dtb[lane];
#pragma unroll
        for (int r = 0; r < NR; ++r) { const int t = (m0 + r) % TP;
            BETA[(size_t)(m0 + r) * 4 + lane] = t >= PADF ? sigmoidf_(db[r]) : 0.f;
            GGp[(size_t)(m0 + r) * 4 + lane] = ae * softplusf_(da[r] + bias); } }
}

__global__ void __launch_bounds__(512, 2) fwd_kernel(Args a_kernarg) {
    extern __shared__ __attribute__((aligned(16))) unsigned char lds_raw[];
    LAS unsigned char* lds = (LAS unsigned char*)lds_raw;
    const int G = gridDim.x;
    const int wave_s = __builtin_amdgcn_readfirstlane(threadIdx.x >> 6);
    for (int u = threadIdx.x; u < (LDS_BYTES - LDS_CTL) / 4; u += 512) ((LAS unsigned*)(lds + LDS_CTL))[u] = 0u;
    __syncthreads();
    (void)xcd_barrier_post((unsigned*)(gp(a_kernarg.ws) + WS_CTL) + CW_BAR, (volatile LAS unsigned*)(lds + MISC_OFF) + 8, (int)threadIdx.x);
#define GRID_BARRIER() do { const int tb_ = (wave_s << 6) + fresh_lane(); \
        const __attribute__((address_space(4))) Args* apb_ = (const __attribute__((address_space(4))) Args*)__builtin_amdgcn_kernarg_segment_ptr(); asm volatile("" : "+s"(apb_)); \
        XcdBarrier bar_; bar_.bar = (unsigned*)(gp(apb_->ws) + WS_CTL) + CW_BAR; bar_.x = xb_xcc_id(); bar_.st = (volatile LAS unsigned*)(lds + MISC_OFF) + 8; xcd_barrier(bar_, tb_); } while (0)

    {
        const int layer = 0; PHASE_LOCALS
        const int gt = blockIdx.x * 512 + tid, NGT = G * 512;
        for (int i = gt; i < NB * FRONTR * DM; i += NGT) { const int c = i % DM, t = (i / DM) % FRONTR; FRONT[i] = t >= PADF ? gp(ap->meta)[(t - PADF) * DM + c] : 0.f; }
        if (FRONT_MODE & 1) {
            unsigned z0; asm volatile("v_mov_b32 %0, 0" : "=v"(z0)); const v4u zz = {z0, z0, z0, z0};
            for (int i = gt; i < 11 * NB * PADF * (BW / 8); i += NGT) { const int cc = i % (BW / 8), rr = (i / (BW / 8)) % PADF, bb = (i / ((BW / 8) * PADF)) % NB, aa = i / ((BW / 8) * PADF * NB);
                *(v4u*)(ARR + (size_t)aa * ASZ + ((size_t)bb * TP + rr) * BW + cc * 8) = zz; }
            bf16* HALO = (bf16*)(ws + WS_HALO);
            for (int i = gt; i < 3 * NB * 3 * (BW / 8); i += NGT) { const int cc = i % (BW / 8), rr = (i / (BW / 8)) % 3, bb = (i / ((BW / 8) * 3)) % NB, aa = i / ((BW / 8) * 3 * NB);
                *(v4u*)(HALO + (((size_t)aa * (R / 64) + bb * NCH) * 3 + rr) * BW + cc * 8) = zz; }
        }
        for (int i = gt; i < BW; i += NGT) { float lg[NLAYER], mx = -1e30f;
#pragma unroll
            for (int l = 0; l < NLAYER; ++l) { lg[l] = gp(ap->lb_logits)[l * BW + i]; mx = fmaxf(mx, lg[l]); }
            float s = 0.f;
#pragma unroll
            for (int l = 0; l < NLAYER; ++l) { lg[l] = __expf(lg[l] - mx); s += lg[l]; }
            float c = 0.f; LB[i] = 0.f;
#pragma unroll
            for (int l = 1; l < NLAYER; ++l) { c += lg[l] / s; LB[l * BW + i] = c; } }
        for (int i = gt; i < NLAYER * 8 * DM; i += NGT) { const int k = i % DM, c = (i / DM) % 8, l = i / (8 * DM); WBA[i] = gp(ap->w_in)[((size_t)l * DM + k) * NIN + 4096 + c]; }
    }
    GRID_BARRIER();

#pragma unroll 1
    for (int layer = 0; layer < NLAYER; ++layer) {
        {
            PHASE_LOCALS
            {
        LAS float* scr = (LAS float*)(lds + wave * 16384);
            constexpr int I_IN = (DM / 64) * (NINP / 32), I_B = 3 * (BW / 64) * (DM / 32), I_O = (DM / 64) * (DM / 32), I_L = I_IN + I_B + I_O;
            for (int it = gw; it < I_L; it += NGW) {
                const int l = layer; int r = it; bf16* wl = (bf16*)(ws + WS_W);
                if (r < I_IN) { const int kb = r / (NINP / 32), nb = r % (NINP / 32);
                    p0_transpose_item(gp(ap->w_in) + (size_t)l * DM * NIN, NIN, in_src_col(nb * 32), wl, DM, nb * 32, scr, kb * 64, lane); continue; }
                r -= I_IN;
                if (r < I_B) { const int br = r / ((BW / 64) * (DM / 32)), rr = r % ((BW / 64) * (DM / 32)); const int kb = rr / (DM / 32), nb = rr % (DM / 32);
                    p0_transpose_item(gp(ap->w_branch) + ((size_t)l * 3 + br) * BW * DM, DM, nb * 32, (bf16*)((unsigned char*)wl + W_IN_BYTES) + (size_t)br * DM * BW, BW, nb * 32, scr, kb * 64, lane); continue; }
                r -= I_B;
                { const int kb = r / (DM / 32), nb = r % (DM / 32);
                  p0_transpose_item(gp(ap->w_out) + (size_t)l * DM * DM, DM, nb * 32, (bf16*)((unsigned char*)wl + W_IN_BYTES + W_B_BYTES), DM, nb * 32, scr, kb * 64, lane); }
            }
            }
            { const float* nw = gp(ap->norm_w) + layer * DM; const float* wba = WBA + layer * 8 * DM; const float* alg = gp(ap->a_log) + layer * NH; const float* dtb = gp(ap->dt_bias) + layer * NH;
              const int NG4 = (R / 4) / NGW * NGW;
              for (int g4 = gw; g4 < NG4; g4 += NGW) p1_rows<4>(FRONT, hin_big, XN, BETA, GGp, nw, wba, alg, dtb, 4 * g4, lane);
              for (int m = 4 * NG4 + gw; m < R; m += NGW) p1_rows<1>(FRONT, hin_big, XN, BETA, GGp, nw, wba, alg, dtb, m, lane); }
        }
        GRID_BARRIER();
        {
            PHASE_LOCALS
            if (FRONT_MODE & 1) {
                bf16* HALO = (bf16*)(ws + WS_HALO);
                unsigned char* MX = (unsigned char*)(ws + WS_MIX); float* ZF = (float*)(ws + WS_ZF);
                { const int slot = wave >> 1, sl = wave & 1; constexpr int NT = (NA + 1536 + 3072) / 16;
                  for (int t0 = blockIdx.x * 4; t0 < NT; t0 += G * 4) { const int tile = t0 + slot; f32x4 acc = {0.f, 0.f, 0.f, 0.f};
                      if (tile < NT) acc = skinny_part<16>(XN + (size_t)PADF * DM, DM, Wt_in, DM, tile, lane, 16 * sl);
                      *(LAS f32x4*)(lds + wave * 1024 + lane * 16) = acc; LDS_BARRIER();
                      if (sl == 0 && tile < NT) { acc += *(const LAS f32x4*)(lds + (wave + 1) * 1024 + lane * 16);
                          if (tile < NA / 16) { const int col = 16 * tile + (lane & 15), t = col >> 9, c = col & 511;
#pragma unroll
                              for (int r = 0; r < 4; ++r) { const int i = 4 * (lane >> 4) + r; const bf16 v = (bf16)f2bf(acc[r]);
#pragma unroll
                                  for (int bb = 0; bb < NB; ++bb) { ARR[(size_t)t * ASZ + ((size_t)bb * TP + PADF + i) * BW + c] = v;
                                      if (t >= 2 && t <= 4 && i >= 13) HALO[(((size_t)(t - 2) * (R / 64) + bb * NCH + 1) * 3 + (i - 13)) * BW + c] = v; } } }
                          else if (tile < (NA + 1536) / 16) { const int col = 16 * tile - NA + (lane & 15);
#pragma unroll
                              for (int r = 0; r < 4; ++r) { const int i = 4 * (lane >> 4) + r; const float z = acc[r]; ZF[i * 1536 + col] = z * sigmoidf_(z); } }
                          else { const int col = 16 * tile - (NA + 1536) + (lane & 15), t = col >> 10, c = col & 1023;
#pragma unroll
                              for (int r = 0; r < 4; ++r) { const int i = 4 * (lane >> 4) + r; unsigned qq = (unsigned)(255.f * sigmoidf_(acc[r]) + 0.5f); qq = qq < 1u ? 1u : qq; const unsigned char q = (unsigned char)qq;
#pragma unroll
                                  for (int bb = 0; bb < NB; ++bb) MX[(size_t)t * R * DM + ((size_t)bb * TP + PADF + i) * DM + c] = q; } } }
                      LDS_BARRIER(); } }
                { unsigned z0; asm volatile("v_mov_b32 %0, 0" : "=v"(z0)); const v4u zz = {z0, z0, z0, z0};
                  for (int i = blockIdx.x * 512 + tid; i < NB * PADF * (BW / 8); i += G * 512) { const int cc = i % (BW / 8), rr = (i / (BW / 8)) % PADF, bb = i / ((BW / 8) * PADF);
                      *(v4u*)(ARR + (size_t)6 * ASZ + ((size_t)bb * TP + rr) * BW + cc * 8) = zz; } }
            }
            pg8::Gemm g{XN, Wt_in, (FRONT_MODE & 1) ? MREAL : R, NA, DM}; pg8::StaticOrder S; S.init((FRONT_MODE & 1) ? MREAL : R, NA, G, (int)blockIdx.x, FRONT_MODE & 1);
            pg8::EpiSplit E{ARR, (float*)(ws + WS_SSQ), (bf16*)(ws + WS_HALO)};
            pg8::gemm_phase<pg8::EpiSplit, pg8::StaticOrder, true, true>(lds, g, S, E, tid);
        }
        GRID_BARRIER();
        constexpr int C1 = 28, C2 = 66, A1 = 0, A2 = 0, M1 = 0, M2 = 0;
#define GDN_LD_(rw, itx) do { const int i_ = (itx) < nit_ ? (itx) : 0; gdn_local_load(rw, ARR + 2 * ASZ, ARR + 3 * ASZ, ARR + 4 * ASZ, (const bf16*)(ws + WS_HALO), BETA, GGp, (i_ % 16) >> 2, nlo_ + i_ / 16, i_ & 3, tid_); } while (0)
#define GDN_IT_(rw, itx) gdn_local_item(rw, ARR + 2 * ASZ, ARR + 3 * ASZ, ARR + 4 * ASZ, ARR + 9 * ASZ, (bf16*)(ws + WS_AQK), (float*)(ws + WS_GL), gp(ap->conv_w) + (size_t)layer * 4 * 1536, ((itx) % 16) >> 2, nlo_ + (itx) / 16, (itx) & 3, lds, tid_)
#define HG_LD_(rw, itx) do { const int i_ = (itx) < nit_ ? (itx) : 0; hg_local_load(rw, ARR + 5 * ASZ, ARR + 6 * ASZ, ARR + 7 * ASZ, (i_ % 16) >> 2, nlo_ + i_ / 16, i_ & 3, tid_); } while (0)
#define HG_IT_(rw, itx) hg_local_item(rw, ARR + 5 * ASZ, ARR + 6 * ASZ, ARR + 7 * ASZ, ARR + 10 * ASZ, (float*)(ws + WS_DEND), LB + layer * BW, ((itx) % 16) >> 2, nlo_ + (itx) / 16, (itx) & 3, lds, tid_)
#define LOCAL_ITEMS(nlo, nhi, WG0, NWG) do { \
            { const int tid_ = (wave_s << 6) + fresh_lane(); const int nlo_ = (nlo), nit_ = 16 * ((nhi) - (nlo)); GdnRaw rwa_, rwb_; GDN_LD_(rwa_, (WG0)); \
              for (int it = (WG0); it < nit_; it += 2 * (NWG)) { GDN_LD_(rwb_, it + (NWG)); GDN_IT_(rwa_, it); GDN_LD_(rwa_, it + 2 * (NWG)); if (it + (NWG) < nit_) GDN_IT_(rwb_, it + (NWG)); } } \
            { const int tid_ = (wave_s << 6) + fresh_lane(); const int nlo_ = (nlo), nit_ = 16 * ((nhi) - (nlo)); HgRaw rwa_, rwb_; HG_LD_(rwa_, (WG0)); \
              for (int it = (WG0); it < nit_; it += 2 * (NWG)) { HG_LD_(rwb_, it + (NWG)); HG_IT_(rwa_, it); HG_LD_(rwa_, it + 2 * (NWG)); if (it + (NWG) < nit_) HG_IT_(rwb_, it + (NWG)); } } } while (0)
#define MIX_ROUNDS(r0, r1) do { pg8::Gemm g{XN, Wt_in + (size_t)(NA + 1536) * DM, (FRONT_MODE & 2) ? MREAL : R, 3072, DM}; pg8::RangeOrder S; S.init((FRONT_MODE & 2) ? MREAL : R, 3072, NW_, (int)blockIdx.x, (FRONT_MODE & 2) ? 1 : 0); S.i0 = (r0); S.i1 = (r1); \
            pg8::EpiMixU8 E{(unsigned char*)(ws + WS_MIX)}; pg8::gemm_phase<pg8::EpiMixU8, pg8::RangeOrder, true, true>(lds, g, S, E, (wave_s << 6) + fresh_lane()); } while (0)
#define ATT_RANGE(lo, hi) do { \
            if ((lo) < (hi)) { const int t_ = (wave_s << 6) + fresh_lane(); if (t_ < 32) *(LAS f32x4*)(lds + SBL_QKT + 16 * t_) = *(const f32x4*)(gp(ap->sb_qn) + layer * HD + 4 * t_) * *(const f32x4*)(gp(ap->sb_kn) + layer * HD + 4 * t_); __syncthreads(); } \
            for (int it = (lo) + (int)blockIdx.x; it < (hi); it += NW_) { const int ui = 31 - it / 16, bh = it % 16; \
                if (ui >= 0) sb_unit(ARR + 8 * ASZ, ARR, ARR + ASZ, (const float*)(ws + WS_RKT), bh >> 2, bh & 3, ui, lds, (wave_s << 6) + fresh_lane()); \
                else { sb_naive_item(ARR + 8 * ASZ, ARR, ARR + ASZ, ARR + 8 * ASZ, gp(ap->sb_qn) + layer * HD, gp(ap->sb_kn) + layer * HD, bh >> 2, bh & 3, 0, (wave_s << 6) + fresh_lane()); __syncthreads(); } } \
            __syncthreads(); } while (0)
#define CHAIN_SEG(nb_, ne_, first_) do { \
            if (cw < 16) gdn_chain2(ARR + 2 * ASZ, ARR + 3 * ASZ, ARR + 4 * ASZ, ARR + 9 * ASZ, (const bf16*)(ws + WS_AQK), (const float*)(ws + WS_GL), gp(ap->gdn_on) + layer * HD, cw >> 2, cw & 3, lds, (wave_s << 6) + fresh_lane(), nb_, ne_, first_); \
            else hg_chain2(ARR + 5 * ASZ, ARR + 6 * ASZ, ARR + 7 * ASZ, ARR + 10 * ASZ, (const float*)(ws + WS_DEND), gp(ap->hg_on) + layer * HD, (cw - 16) >> 2, (cw - 16) & 3, lds, (wave_s << 6) + fresh_lane(), nb_, ne_, first_); } while (0)
        {
            PHASE_LOCALS
            { const float* SSQ = (const float*)(ws + WS_SSQ); float* RKT = (float*)(ws + WS_RKT);
              for (int i = blockIdx.x * 512 + tid; i < R * 4; i += G * 512) { const int row = i >> 2, hh = i & 3, t = row % TP;
                  if ((FRONT_MODE & 1) && t < FRONTR) { float ss = 0.f; const bf16* kp = ARR + (size_t)row * BW + hh * HD;
#pragma unroll 4
                      for (int j = 0; j < HD / 8; ++j) { const v4u w = *(const v4u*)(kp + 8 * j); const float a0 = bflo(w.x), a1 = bfhi(w.x), a2 = bflo(w.y), a3 = bfhi(w.y), a4 = bflo(w.z), a5 = bfhi(w.z), a6 = bflo(w.w), a7 = bfhi(w.w);
                          ss += (a0 * a0 + a1 * a1) + (a2 * a2 + a3 * a3) + (a4 * a4 + a5 * a5) + (a6 * a6 + a7 * a7); }
                      RKT[i] = rsqrtf(ss * (1.f / HD) + EPS); }
                  else { const f32x4 q4 = *(const f32x4*)(SSQ + (size_t)i * 4); RKT[i] = rsqrtf(((q4[0] + q4[1]) + (q4[2] + q4[3])) * (1.f / HD) + EPS); } } }
            LOCAL_ITEMS(0, C1, (int)blockIdx.x, G);
        }
        GRID_BARRIER();
        {
            const int cw = (int)blockIdx.x - (G - 32); const int NW_ = G - 32;
            { PHASE_LOCALS
              if (cw >= 0) CHAIN_SEG(0, C1, true); else { LOCAL_ITEMS(C1, C2, (int)blockIdx.x, NW_); ATT_RANGE(0, A1); if (M1 > 0) MIX_ROUNDS(0, M1); } }
            GRID_BARRIER();
            { PHASE_LOCALS
              if (cw >= 0) CHAIN_SEG(C1, C2, false);
              else { LOCAL_ITEMS(C2, NCH, (int)blockIdx.x, NW_); ATT_RANGE(A1, A2); if (M2 > M1) MIX_ROUNDS(M1, M2); } }
            GRID_BARRIER();
            { PHASE_LOCALS
              if (cw >= 0) CHAIN_SEG(C2, NCH, false);
              else {
                  ATT_RANGE(A2, 16 * 33);
                  MIX_ROUNDS(M2, 1 << 20); } }
        }
#undef LOCAL_ITEMS
#undef MIX_ROUNDS
#undef CHAIN_SEG
#undef ATT_RANGE
        GRID_BARRIER();
        {
            PHASE_LOCALS
            if (FRONT_MODE & 4) {
                const float* ZF = (const float*)(ws + WS_ZF);
                for (int i = blockIdx.x * 512 + tid; i < NB * 16 * (1536 / 8); i += G * 512) { const int c8 = i % 192, row = (i / 192) % 16, bb = i / (192 * 16); const int col = 8 * c8, t = col >> 9, c = col & 511;
                    bf16* op = OARR + (size_t)t * ASZ + ((size_t)bb * TP + PADF + row) * BW + c; const v4u o = *(const v4u*)op; const f32x4 g0 = *(const f32x4*)(ZF + row * 1536 + col), g1 = *(const f32x4*)(ZF + row * 1536 + col + 4);
                    v4u w; w.x = pk2(bflo(o.x) * g0[0], bfhi(o.x) * g0[1]); w.y = pk2(bflo(o.y) * g0[2], bfhi(o.y) * g0[3]); w.z = pk2(bflo(o.z) * g1[0], bfhi(o.z) * g1[1]); w.w = pk2(bflo(o.w) * g1[2], bfhi(o.w) * g1[3]);
                    *(v4u*)op = w; } }
            pg8::Gemm g{XN, Wt_in + (size_t)NA * DM, (FRONT_MODE & 4) ? MREAL : R, 1536, DM}; pg8::StaticOrder S; S.init((FRONT_MODE & 4) ? MREAL : R, 1536, G, (int)blockIdx.x, (FRONT_MODE & 4) ? 1 : 0);
            pg8::EpiZ E{OARR};
            pg8::gemm_phase<pg8::EpiZ, pg8::StaticOrder, true, true>(lds, g, S, E, tid);
        }
        GRID_BARRIER();
        if (FRONT_MODE & 8) { PHASE_LOCALS
            const unsigned char* MX = (const unsigned char*)(ws + WS_MIX); bf16* YF = (bf16*)(ws + WS_YF);
            for (int tile = blockIdx.x; tile < DM / 16; tile += G) { f32x4 acc = {0.f, 0.f, 0.f, 0.f}; const int br = wave >> 1, sl = wave & 1;
                if (wave < 6) acc = skinny_part<8>(OARR + (size_t)br * ASZ + (size_t)PADF * BW, BW, Wt_B + (size_t)br * DM * BW, BW, tile, lane, 8 * sl);
                *(LAS f32x4*)(lds + wave * 1024 + lane * 16) = acc; LDS_BARRIER();
                if (wave == 0) { f32x4 y = {0.f, 0.f, 0.f, 0.f}; const int col = 16 * tile + (lane & 15);
#pragma unroll
                    for (int b3 = 0; b3 < 3; ++b3) { const f32x4 p = *(const LAS f32x4*)(lds + (2 * b3) * 1024 + lane * 16) + *(const LAS f32x4*)(lds + (2 * b3 + 1) * 1024 + lane * 16);
#pragma unroll
                        for (int r = 0; r < 4; ++r) { const int i = 4 * (lane >> 4) + r; y[r] += p[r] * ((float)MX[(size_t)b3 * R * DM + ((size_t)PADF + i) * DM + col] * (1.f / 255.f)); } }
#pragma unroll
                    for (int r = 0; r < 4; ++r) YF[(4 * (lane >> 4) + r) * DM + col] = (bf16)f2bf(y[r]); }
                LDS_BARRIER(); } }
        {
            PHASE_LOCALS
            pg8::StaticOrder S; S.init((FRONT_MODE & 8) ? MREAL : R, DM, G, (int)blockIdx.x, (FRONT_MODE & 8) ? 1 : 0);
            pg8::Gemm g{OARR, Wt_B, (FRONT_MODE & 8) ? MREAL : R, DM, BW, 3, (size_t)ASZ * 2, (size_t)DM * BW * 2};
            pg8::EpiYseg E{XN, (const unsigned char*)(ws + WS_MIX)};
            pg8::gemm_phase<pg8::EpiYseg, pg8::StaticOrder, true, true>(lds, g, S, E, tid);
        }
        GRID_BARRIER();
        {
            PHASE_LOCALS
            if (FRONT_MODE & 16) { const bf16* YF = (const bf16*)(ws + WS_YF);
                for (int tile = blockIdx.x; tile < DM / 16; tile += G) { f32x4 acc = skinny_part<4>(YF, DM, Wt_O, DM, tile, lane, 4 * wave);
                    *(LAS f32x4*)(lds + wave * 1024 + lane * 16) = acc; LDS_BARRIER();
                    if (wave == 0) { const int col = 16 * tile + (lane & 15);
#pragma unroll
                        for (int w2 = 1; w2 < 8; ++w2) acc += *(const LAS f32x4*)(lds + w2 * 1024 + lane * 16);
#pragma unroll
                        for (int r = 0; r < 4; ++r) { const int i = 4 * (lane >> 4) + r;
#pragma unroll
                            for (int bb = 0; bb < NB; ++bb) FRONT[((size_t)bb * FRONTR + PADF + i) * DM + col] += acc[r]; } }
                    LDS_BARRIER(); } }
            pg8::Gemm g{XN, Wt_O, (FRONT_MODE & 16) ? MREAL : R, DM, DM}; pg8::StaticOrder S; S.init((FRONT_MODE & 16) ? MREAL : R, DM, G, (int)blockIdx.x, (FRONT_MODE & 16) ? 1 : 0);
            pg8::EpiRes E{FRONT, hin_big, FRONT, gp(ap->out)};
            pg8::gemm_phase<pg8::EpiRes, pg8::StaticOrder, true, true>(lds, g, S, E, tid);
        }
        GRID_BARRIER();
    }
}

extern "C" void kernel_launch(void* const* d_in, const int* in_sizes, int n_in, void* d_out, int out_size, void* d_ws, size_t ws_size, hipStream_t stream) {
    static int grid = 0;
    if (grid == 0) {
        if (n_in != 14 || ws_size < WS_END) { fprintf(stderr, "kernel_launch: need 14 inputs and %zu bytes of workspace (got %d, %zu)\n", (size_t)WS_END, n_in, ws_size); grid = -1; return; }
        int dev = 0, cus = 0, per_cu = 0;
        hipGetDevice(&dev); hipDeviceGetAttribute(&cus, hipDeviceAttributeMultiprocessorCount, dev);
        if (hipFuncSetAttribute((const void*)fwd_kernel, hipFuncAttributeMaxDynamicSharedMemorySize, LDS_BYTES) != hipSuccess) { fprintf(stderr, "kernel_launch: hipFuncSetAttribute failed\n"); grid = -1; return; }
        hipOccupancyMaxActiveBlocksPerMultiprocessor(&per_cu, (const void*)fwd_kernel, 512, LDS_BYTES);
        (void)hipGetLastError();
        if (per_cu < 1) fprintf(stderr, "kernel_launch: occupancy query reports %d\n", per_cu);
        grid = cus;
    }
    if (grid < 0) return;
    hipMemsetAsync((char*)d_ws + WS_CTL, 0, CTL_ZERO_BYTES, stream);
    Args a{};
    a.x = (const float*)d_in[0]; a.meta = (const float*)d_in[1]; a.norm_w = (const float*)d_in[2]; a.w_in = (const float*)d_in[3]; a.sb_qn = (const float*)d_in[4]; a.sb_kn = (const float*)d_in[5];
    a.conv_w = (const float*)d_in[6]; a.a_log = (const float*)d_in[7]; a.dt_bias = (const float*)d_in[8]; a.gdn_on = (const float*)d_in[9]; a.lb_logits = (const float*)d_in[10]; a.hg_on = (const float*)d_in[11];
    a.w_branch = (const float*)d_in[12]; a.w_out = (const float*)d_in[13]; a.out = (float*)d_out; a.ws = (unsigned char*)d_ws;
    hipLaunchKernelGGL(fwd_kernel, dim3(grid), dim3(512), LDS_BYTES, stream, a);
}
```
